# Optimizing an MI355X kernel written in HIP

```python
import math
import jax, jax.numpy as jnp
from jax import lax
import numpy as np

D_MODEL = 1024
BATCH = 4
SEQ = 8192
DEPTH = 2
DEC_BATCH = 16
DEC_SEQ = 16
PAST_LEN = 1024

CHUNK = 64
N_HEADS = 16
HEAD_DIM = D_MODEL // N_HEADS
D_FF = 4 * D_MODEL
BAND_CHUNKS = 8
WINDOW = BAND_CHUNKS * CHUNK
REL_CLIP = 256
N_REL = 2 * REL_CLIP + 1
Q_BLOCK = 128
N_BAND_LAYERS = (DEPTH + 1) // 2
N_FOX_LAYERS = DEPTH // 2
RMS_EPS = 1e-6
NEG_INF = -1e30

kernel_name = "streaming_band_fox_macaron_encoder"


def rmsnorm(x, g):
    xf = x.astype(jnp.float32)
    y = xf * lax.rsqrt(jnp.mean(xf * xf, axis=-1, keepdims=True) + RMS_EPS)
    return (y * g.astype(jnp.float32)).astype(x.dtype)


def swiglu(h, w_gate, w_up, w_down):
    return (jax.nn.silu(h @ w_gate) * (h @ w_up)) @ w_down


def half_ffn(x, g, w_gate, w_up, w_down):
    return x + 0.5 * swiglu(rmsnorm(x, g), w_gate, w_up, w_down)


def qkv_proj(h, w_qkv):
    q, k, v = jnp.split(h @ w_qkv, 3, axis=-1)
    shp = h.shape[:-1] + (N_HEADS, HEAD_DIM)
    return q.reshape(shp), k.reshape(shp), v.reshape(shp)


def attend(q, k, v, bias, valid):
    s = jnp.einsum("bqhd,bkhd->bhqk", q, k, preferred_element_type=jnp.float32) * (HEAD_DIM ** -0.5) + bias
    p = jax.nn.softmax(jnp.where(valid, s, NEG_INF), axis=-1)
    return jnp.einsum("bhqk,bkhd->bqhd", p.astype(v.dtype), v)


def rel_position_bias(dist, table):
    idx = jnp.clip(dist, -REL_CLIP, REL_CLIP) + REL_CLIP
    return jnp.moveaxis(table[idx], -1, 0)[None].astype(jnp.float32)


def band_attention_prompt(q, k, v, table):
    B, T = q.shape[:2]
    n_chunks = T // CHUNK
    band = WINDOW + CHUNK
    pad = ((0, 0), (WINDOW, 0), (0, 0), (0, 0))
    kp, vp = jnp.pad(k, pad), jnp.pad(v, pad)
    qc = q.reshape(B, n_chunks, CHUNK, N_HEADS, HEAD_DIM).swapaxes(0, 1)
    q_rel = jnp.arange(CHUNK)
    k_rel = jnp.arange(band) - WINDOW
    bias = rel_position_bias(q_rel[:, None] - k_rel[None, :], table)

    def one_chunk(args):
        c, qb = args
        start = c * CHUNK
        kb = lax.dynamic_slice_in_dim(kp, start, band, axis=1)
        vb = lax.dynamic_slice_in_dim(vp, start, band, axis=1)
        valid = (start + k_rel >= 0)[None, None, None, :]
        return attend(qb, kb, vb, bias, valid)

    out = lax.map(one_chunk, (jnp.arange(n_chunks), qc))
    return out.swapaxes(0, 1).reshape(B, T, N_HEADS, HEAD_DIM)


def band_attention_sample(q, k_new, v_new, k_cache, v_cache, table):
    T = q.shape[1]
    wc = k_cache.shape[1]
    k = jnp.concatenate([k_cache.astype(k_new.dtype), k_new], axis=1)
    v = jnp.concatenate([v_cache.astype(v_new.dtype), v_new], axis=1)
    q_pos = PAST_LEN + jnp.arange(T)
    k_pos = jnp.concatenate([PAST_LEN - wc + jnp.arange(wc), q_pos])
    bias = rel_position_bias(q_pos[:, None] - k_pos[None, :], table)
    q_chunk, k_chunk = q_pos[:, None] // CHUNK, k_pos[None, :] // CHUNK
    valid = ((k_chunk <= q_chunk) & (k_chunk >= q_chunk - BAND_CHUNKS))[None, None]
    return attend(q, k, v, bias, valid)


def log_forget(h, w_f, b_f):
    return jax.nn.log_sigmoid(jnp.einsum("btd,dh->bth", h, w_f, preferred_element_type=jnp.float32)
                              + b_f.astype(jnp.float32))


def fox_prompt(q, k, v, logf):
    B, T = q.shape[:2]
    n_blocks = T // Q_BLOCK
    cum = lax.cumsum(logf, axis=1)
    cum_k = cum.swapaxes(1, 2)
    qb = q.reshape(B, n_blocks, Q_BLOCK, N_HEADS, HEAD_DIM).swapaxes(0, 1)
    cb = cum.reshape(B, n_blocks, Q_BLOCK, N_HEADS).swapaxes(0, 1)
    k_pos = jnp.arange(T)

    def one_block(args):
        i, qi, ci = args
        q_pos = i * Q_BLOCK + jnp.arange(Q_BLOCK)
        bias = ci.swapaxes(1, 2)[..., None] - cum_k[:, :, None, :]
        valid = (k_pos[None, :] <= q_pos[:, None])[None, None]
        return attend(qi, k, v, bias, valid)

    out = lax.map(one_block, (jnp.arange(n_blocks), qb, cb))
    return out.swapaxes(0, 1).reshape(B, T, N_HEADS, HEAD_DIM)


def fox_sample(q, k_new, v_new, logf_new, k_cache, v_cache, logf_cache):
    T = q.shape[1]
    P = k_cache.shape[1]
    k = jnp.concatenate([k_cache.astype(k_new.dtype), k_new], axis=1)
    v = jnp.concatenate([v_cache.astype(v_new.dtype), v_new], axis=1)
    cum = lax.cumsum(jnp.concatenate([logf_cache.astype(jnp.float32), logf_new], axis=1), axis=1)
    bias = cum[:, P:].swapaxes(1, 2)[..., None] - cum.swapaxes(1, 2)[:, :, None, :]
    valid = (jnp.arange(P + T)[None, :] <= (P + jnp.arange(T))[:, None])[None, None]
    return attend(q, k, v, bias, valid)


def setup_inputs(seed: int = 0) -> dict:
    key = jax.random.key(seed)
    ks = jax.random.split(key, 20)
    win_cache = min(WINDOW, PAST_LEN)

    def nrm(k, shape, scale):
        return jax.random.normal(k, shape, jnp.float32) * scale

    return {
        "x_prompt": nrm(ks[0], (BATCH, SEQ, D_MODEL), 1.0),
        "x_sample": nrm(ks[1], (DEC_BATCH, DEC_SEQ, D_MODEL), 1.0),
        "cache_band_k": nrm(ks[2], (N_BAND_LAYERS, DEC_BATCH, win_cache, N_HEADS, HEAD_DIM), 1.0),
        "cache_band_v": nrm(ks[3], (N_BAND_LAYERS, DEC_BATCH, win_cache, N_HEADS, HEAD_DIM), 1.0),
        "cache_fox_k": nrm(ks[4], (N_FOX_LAYERS, DEC_BATCH, PAST_LEN, N_HEADS, HEAD_DIM), 1.0),
        "cache_fox_v": nrm(ks[5], (N_FOX_LAYERS, DEC_BATCH, PAST_LEN, N_HEADS, HEAD_DIM), 1.0),
        "cache_fox_logf": jax.nn.log_sigmoid(3.0 + nrm(ks[6], (N_FOX_LAYERS, DEC_BATCH, PAST_LEN, N_HEADS), 1.0)),
        "norm_g": 1.0 + nrm(ks[7], (DEPTH, 3, D_MODEL), 0.05),
        "w_qkv": nrm(ks[8], (DEPTH, D_MODEL, 3 * D_MODEL), D_MODEL ** -0.5),
        "w_o": nrm(ks[9], (DEPTH, D_MODEL, D_MODEL), D_MODEL ** -0.5),
        "w_ffn_gate": nrm(ks[10], (DEPTH, 2, D_MODEL, D_FF), D_MODEL ** -0.5),
        "w_ffn_up": nrm(ks[11], (DEPTH, 2, D_MODEL, D_FF), D_MODEL ** -0.5),
        "w_ffn_down": nrm(ks[12], (DEPTH, 2, D_FF, D_MODEL), D_FF ** -0.5),
        "rel_bias": nrm(ks[13], (N_BAND_LAYERS, N_REL, N_HEADS), 0.5),
        "w_forget": nrm(ks[14], (N_FOX_LAYERS, D_MODEL, N_HEADS), D_MODEL ** -0.5),
        "b_forget": jnp.linspace(1.0, 5.0, N_HEADS, dtype=jnp.float32)[None, :]
                     + nrm(ks[15], (N_FOX_LAYERS, N_HEADS), 0.1),
        "final_norm_g": 1.0 + nrm(ks[16], (D_MODEL,), 0.05),
    }


def reference(x_prompt, x_sample, cache_band_k, cache_band_v, cache_fox_k, cache_fox_v, cache_fox_logf,
              norm_g, w_qkv, w_o, w_ffn_gate, w_ffn_up, w_ffn_down, rel_bias, w_forget, b_forget,
              final_norm_g):
    xp, xs = x_prompt, x_sample
    band_kp, band_vp, band_ks, band_vs = [], [], [], []
    fox_kp, fox_vp, fox_lp, fox_ks, fox_vs, fox_ls = [], [], [], [], [], []
    for layer in range(DEPTH):
        ffn_a = (norm_g[layer, 0], w_ffn_gate[layer, 0], w_ffn_up[layer, 0], w_ffn_down[layer, 0])
        xp = half_ffn(xp, *ffn_a)
        xs = half_ffn(xs, *ffn_a)
        hp = rmsnorm(xp, norm_g[layer, 1])
        hs = rmsnorm(xs, norm_g[layer, 1])
        qp, kp, vp = qkv_proj(hp, w_qkv[layer])
        qs, ks_, vs_ = qkv_proj(hs, w_qkv[layer])
        if layer % 2 == 0:
            a = layer // 2
            op = band_attention_prompt(qp, kp, vp, rel_bias[a])
            os_ = band_attention_sample(qs, ks_, vs_, cache_band_k[a], cache_band_v[a], rel_bias[a])
            keep = max(kp.shape[1] - WINDOW, 0)
            band_kp.append(kp[:, keep:])
            band_vp.append(vp[:, keep:])
            band_ks.append(ks_)
            band_vs.append(vs_)
        else:
            b = layer // 2
            lfp = log_forget(hp, w_forget[b], b_forget[b])
            lfs = log_forget(hs, w_forget[b], b_forget[b])
            op = fox_prompt(qp, kp, vp, lfp)
            os_ = fox_sample(qs, ks_, vs_, lfs, cache_fox_k[b], cache_fox_v[b], cache_fox_logf[b])
            fox_kp.append(kp)
            fox_vp.append(vp)
            fox_lp.append(lfp)
            fox_ks.append(ks_)
            fox_vs.append(vs_)
            fox_ls.append(lfs)
        xp = xp + op.reshape(xp.shape) @ w_o[layer]
        xs = xs + os_.reshape(xs.shape) @ w_o[layer]
        ffn_b = (norm_g[layer, 2], w_ffn_gate[layer, 1], w_ffn_up[layer, 1], w_ffn_down[layer, 1])
        xp = half_ffn(xp, *ffn_b)
        xs = half_ffn(xs, *ffn_b)
    y_prompt = rmsnorm(xp, final_norm_g)
    y_sample = rmsnorm(xs, final_norm_g)
    return (y_prompt, y_sample,
            jnp.stack(band_kp), jnp.stack(band_vp), jnp.stack(band_ks), jnp.stack(band_vs),
            jnp.stack(fox_kp), jnp.stack(fox_vp), jnp.stack(fox_lp),
            jnp.stack(fox_ks), jnp.stack(fox_vs), jnp.stack(fox_ls))
```

```cpp
#include <hip/hip_runtime.h>
#include <hip/hip_cooperative_groups.h>
#include <hip/hip_bf16.h>
#include <cstdio>
#include <cstdint>
#include <cmath>
namespace cg = cooperative_groups;
#define MK_N_LAUNCHES 1
#define PROBE_MASK 0u
namespace pg8 {
#define PG8_LAS __attribute__((address_space(3)))
typedef unsigned short bf16_t;
typedef short bf16x8 __attribute__((ext_vector_type(8)));
typedef float f32x4 __attribute__((ext_vector_type(4)));
typedef unsigned u32x4 __attribute__((ext_vector_type(4)));
constexpr int BM = 256, BK = 64, HALF = 128, HTB = HALF * BK * 2  , STAGE_BYTES = 8 * HTB, NXCD = 8, WGM = 8;

__host__ __device__ __forceinline__ int lds_byte(int r, int c) { const int st = (r >> 4) * 2 + (c >> 5), rr = r & 15, cc = c & 31, ob = rr * 64 + cc * 2; return st * 1024 + (ob ^ (((ob >> 9) & 1) << 5)); }
__host__ __device__ __forceinline__ void stage_rc(int b, int& R, int& C) { const int st = b / 1024, sb = b % 1024, swz = sb ^ (((sb >> 9) & 1) << 5); R = (st >> 1) * 16 + swz / 64; C = (st & 1) * 32 + (swz % 64) / 2; }
__host__ __device__ __forceinline__ int perm32(int rho) { const int n = rho >> 4, i = rho & 15; return 8 * (i >> 2) + 4 * n + (i & 3); }

struct Unit { int pm, pn; };
struct Gemm { const bf16_t* A; const bf16_t* Bt; int M, N, K; };

struct StaticOrder {
    int nM, nN, nwg, G, c;
    __host__ __device__ void init(int M, int N, int G_, int c_) { nM = M / BM; nN = N / BM; nwg = nM * nN; G = G_; c = c_; }
    __host__ __device__ bool next(int i, Unit& u) const {
        const long L = (long)i * G + c; if (L >= nwg) return false;
        int wgid = (int)L; { const int q = nwg / NXCD, r = nwg % NXCD, xcd = wgid % NXCD, off = wgid / NXCD; wgid = (xcd < r ? xcd * (q + 1) : r * (q + 1) + (xcd - r) * q) + off; }
        const int nig = WGM * nN, gid = wgid / nig, fm = gid * WGM, gsz = (nM - fm) < WGM ? (nM - fm) : WGM;
        u.pm = fm + ((wgid % nig) % gsz); u.pn = (wgid % nig) / gsz; return true;
    }
    __device__ __forceinline__ void a_ready(const Unit&) const {}
    __device__ __forceinline__ void done(const Unit&) const {}
};

__device__ __forceinline__ unsigned cvt_pk_bf16(float lo, float hi) { unsigned r; asm volatile("v_cvt_pk_bf16_f32 %0, %1, %2" : "=v"(r) : "v"(lo), "v"(hi)); return r; }
typedef float f32x2 __attribute__((ext_vector_type(2)));
constexpr float RMS_EPS_F = 1e-6f;
__device__ __forceinline__ float rstd_of(float ss) { return __builtin_amdgcn_rsqf(ss * (1.0f / 1024.0f) + RMS_EPS_F); }
__device__ __forceinline__ float silu_mul(float g, float u) { return g * __builtin_amdgcn_rcpf(1.0f + __builtin_amdgcn_exp2f(-1.4426950408889634f * g)) * u; }

struct EpiGateUp {
    static constexpr bool PERM = true, AFTER_DRAIN = false;
    bf16_t* act; const float* rowss;
    __device__ __forceinline__ void operator()(const f32x4 (&acc)[2][2][4][2], const Unit& u, int wr, int wc, int fr_in, int fq_in) const {
        int fr = fr_in, fq = fq_in; asm volatile("" : "+v"(fr), "+v"(fq));
        const int row0 = u.pm * BM + wr * 64 + fr, col0 = u.pn * HALF + wc * 32 + 8 * fq;
        float ssq[2][4];
#pragma unroll
        for (int ai = 0; ai < 2; ++ai)
#pragma unroll
            for (int m = 0; m < 4; ++m) ssq[ai][m] = rowss[row0 + ai * HALF + m * 16];
        asm volatile("" : "+v"(ssq[0][0]), "+v"(ssq[0][1]), "+v"(ssq[0][2]), "+v"(ssq[0][3]), "+v"(ssq[1][0]), "+v"(ssq[1][1]), "+v"(ssq[1][2]), "+v"(ssq[1][3]));
#pragma unroll
        for (int ai = 0; ai < 2; ++ai)
#pragma unroll
            for (int m = 0; m < 4; ++m) { const int row = row0 + ai * HALF + m * 16; const float rs = rstd_of(ssq[ai][m]);
                const f32x4 g0 = acc[ai][0][m][0] * rs, g1 = acc[ai][0][m][1] * rs, u0 = acc[ai][1][m][0] * rs, u1 = acc[ai][1][m][1] * rs;
                u32x4 w; w.x = cvt_pk_bf16(silu_mul(g0[0], u0[0]), silu_mul(g0[1], u0[1])); w.y = cvt_pk_bf16(silu_mul(g0[2], u0[2]), silu_mul(g0[3], u0[3]));
                w.z = cvt_pk_bf16(silu_mul(g1[0], u1[0]), silu_mul(g1[1], u1[1])); w.w = cvt_pk_bf16(silu_mul(g1[2], u1[2]), silu_mul(g1[3], u1[3]));
                *(u32x4*)(act + (size_t)row * 4096 + col0) = w; }
    }
};

template <bool FIRST> struct EpiResid {
    static constexpr bool PERM = true, AFTER_DRAIN = false;
    const float* xin; bf16_t* xb; float* rowss_next; float alpha;
    __device__ __forceinline__ void operator()(const f32x4 (&acc)[2][2][4][2], const Unit& u, int wr, int wc, int fr_in, int fq_in) const {
        int fr = fr_in, fq = fq_in; asm volatile("" : "+v"(fr), "+v"(fq));
        const int row0 = u.pm * BM + wr * 64 + fr, colb = u.pn * BM + wc * 32 + 8 * fq;
#pragma unroll
        for (int ai = 0; ai < 2; ++ai)
#pragma unroll
          for (int mh = 0; mh < 2; ++mh) {
            f32x4 xv[2][2][2];
#pragma unroll
            for (int mm = 0; mm < 2; ++mm)
#pragma unroll
                for (int bj = 0; bj < 2; ++bj) { const size_t o = (size_t)(row0 + ai * HALF + (2 * mh + mm) * 16) * 1024 + colb + bj * HALF;
                    if constexpr (FIRST) { xv[mm][bj][0] = *(const f32x4*)(xin + o); xv[mm][bj][1] = *(const f32x4*)(xin + o + 4); }
                    else { const u32x4 w = *(const u32x4*)(xb + o);
                        xv[mm][bj][0] = (f32x4){__uint_as_float(w.x << 16), __uint_as_float(w.x & 0xffff0000u), __uint_as_float(w.y << 16), __uint_as_float(w.y & 0xffff0000u)};
                        xv[mm][bj][1] = (f32x4){__uint_as_float(w.z << 16), __uint_as_float(w.z & 0xffff0000u), __uint_as_float(w.w << 16), __uint_as_float(w.w & 0xffff0000u)}; } }
#pragma unroll
            for (int mm = 0; mm < 2; ++mm) asm volatile("" : "+v"(xv[mm][0][0]), "+v"(xv[mm][0][1]), "+v"(xv[mm][1][0]), "+v"(xv[mm][1][1]));
#pragma unroll
            for (int mm = 0; mm < 2; ++mm) { const int m = 2 * mh + mm; const int row = row0 + ai * HALF + m * 16; float ss = 0.f;
#pragma unroll
                for (int bj = 0; bj < 2; ++bj) {
                    const f32x4 v0 = xv[mm][bj][0] + acc[ai][bj][m][0] * alpha, v1 = xv[mm][bj][1] + acc[ai][bj][m][1] * alpha;
                    ss += (v0[0] * v0[0] + v0[1] * v0[1]) + (v0[2] * v0[2] + v0[3] * v0[3]) + (v1[0] * v1[0] + v1[1] * v1[1]) + (v1[2] * v1[2] + v1[3] * v1[3]);
                    u32x4 w; w.x = cvt_pk_bf16(v0[0], v0[1]); w.y = cvt_pk_bf16(v0[2], v0[3]); w.z = cvt_pk_bf16(v1[0], v1[1]); w.w = cvt_pk_bf16(v1[2], v1[3]);
                    *(u32x4*)(xb + (size_t)row * 1024 + colb + bj * HALF) = w; }
                ss += __shfl_xor(ss, 16); ss += __shfl_xor(ss, 32);
                if (fq == 0) __hip_atomic_fetch_add(rowss_next + row, ss, __ATOMIC_RELAXED, __HIP_MEMORY_SCOPE_AGENT); } }
    }
};

template <class C> struct EpiQKV {
    static constexpr bool PERM = true, AFTER_DRAIN = false;
    unsigned char* ws; float* out; const float* bfg; int fox; float qscale;
    __device__ __forceinline__ void operator()(const f32x4 (&acc)[2][2][4][2], const Unit& u, int wr, int wc, int fr_in, int fq_in) const {
        int fr = fr_in, fq = fq_in; asm volatile("" : "+v"(fr), "+v"(fq));
        const int t = u.pn >> 2, row0 = u.pm * BM + wr * 64 + fr;
        const float* rowss = (const float*)(ws + C::o_rowss0) + (size_t)(fox ? 4 : 1) * C::mtot;
        if (t == 3) {
            if (wc == 0 && fq < 2) {
                f32x4 bb[2]; bb[0] = *(const f32x4*)(bfg + 8 * fq); bb[1] = *(const f32x4*)(bfg + 8 * fq + 4);
                f32x4 tot[2] = {(f32x4){0.f, 0.f, 0.f, 0.f}, (f32x4){0.f, 0.f, 0.f, 0.f}};
#pragma unroll
                for (int ai = 0; ai < 2; ++ai)
#pragma unroll
                    for (int m = 0; m < 4; ++m) { const int row = row0 + ai * HALF + m * 16; const float rs = rstd_of(rowss[row]);
                        float* dst = (u.pm == 128) ? out + C::o_fls + (size_t)(row - 32768) * 16 : out + C::o_flp + (size_t)row * 16;
#pragma unroll
                        for (int n = 0; n < 2; ++n) { const f32x4 z = acc[ai][0][m][n] * rs + bb[n]; f32x4 lf;
#pragma unroll
                            for (int j = 0; j < 4; ++j) { const float ee = __builtin_amdgcn_exp2f(-1.4426950408889634f * fabsf(z[j]));
                                const float big = 0.6931471805599453f * __builtin_amdgcn_logf(1.0f + ee), sm = ee * (1.0f - ee * (0.5f - ee * (0.3333333333f - 0.25f * ee)));
                                lf[j] = fminf(z[j], 0.f) - (ee < 0.03f ? sm : big); }
                            *(f32x4*)(dst + 8 * fq + 4 * n) = lf; tot[n] += lf; } }
                if (u.pm < 128) { float* blocktot = (float*)(ws + C::o_btot);
#pragma unroll
                    for (int n = 0; n < 2; ++n)
#pragma unroll
                        for (int j = 0; j < 4; ++j) { float s = tot[n][j]; s += __shfl_xor(s, 1); s += __shfl_xor(s, 2); s += __shfl_xor(s, 4); s += __shfl_xor(s, 8);
                            if (fr == 0) __hip_atomic_fetch_add(blocktot + u.pm * 16 + 8 * fq + 4 * n + j, s, __ATOMIC_RELAXED, __HIP_MEMORY_SCOPE_AGENT); }
                }
            }
            return;
        }
        const int cin = (u.pn & 3) * BM + wc * 32 + 8 * fq;
        bf16_t* bdst = (bf16_t*)(ws + ((t == 0) ? C::o_qo : (t == 1) ? C::o_kb : C::o_vb));
        float* fdst = nullptr;
        if (t != 0) { const size_t op = fox ? ((t == 1) ? C::o_fkp : C::o_fvp) : ((t == 1) ? C::o_bkp : C::o_bvp), os = fox ? ((t == 1) ? C::o_fks : C::o_fvs) : ((t == 1) ? C::o_bks : C::o_bvs);
            if (u.pm == 128) fdst = out + os;
            else if (fox) fdst = out + op + (size_t)u.pm * BM * 1024;
            else if ((u.pm & 31) >= 30) fdst = out + op + (size_t)((u.pm >> 5) * 512 + ((u.pm & 31) - 30) * BM) * 1024; }
        const float sc = (t == 0) ? qscale : 1.0f;
        float ssq[2][4];
#pragma unroll
        for (int ai = 0; ai < 2; ++ai)
#pragma unroll
            for (int m = 0; m < 4; ++m) ssq[ai][m] = rowss[row0 + ai * HALF + m * 16];
        asm volatile("" : "+v"(ssq[0][0]), "+v"(ssq[0][1]), "+v"(ssq[0][2]), "+v"(ssq[0][3]), "+v"(ssq[1][0]), "+v"(ssq[1][1]), "+v"(ssq[1][2]), "+v"(ssq[1][3]));
#pragma unroll
        for (int ai = 0; ai < 2; ++ai)
#pragma unroll
            for (int m = 0; m < 4; ++m) { const int rl = wr * 64 + fr + ai * HALF + m * 16, row = u.pm * BM + rl; const float rs = rstd_of(ssq[ai][m]);
#pragma unroll
                for (int bj = 0; bj < 2; ++bj) { const f32x4 v0 = acc[ai][bj][m][0] * rs, v1 = acc[ai][bj][m][1] * rs;
                    if (fdst) { float* fp = fdst + (size_t)rl * 1024 + cin + bj * HALF; *(f32x4*)fp = v0; *(f32x4*)(fp + 4) = v1; }
                    u32x4 w; w.x = cvt_pk_bf16(v0[0] * sc, v0[1] * sc); w.y = cvt_pk_bf16(v0[2] * sc, v0[3] * sc); w.z = cvt_pk_bf16(v1[0] * sc, v1[1] * sc); w.w = cvt_pk_bf16(v1[2] * sc, v1[3] * sc);
                    *(u32x4*)(bdst + (size_t)row * 1024 + cin + bj * HALF) = w; } }
    }
};


template <class Epi, class Sched, bool ALIGN_EPI = false, bool SP2 = false>
__device__ __forceinline__ void gemm_phase(PG8_LAS unsigned char* lds, const Gemm g, const Sched& S, const Epi& E) {
    int tid_ = threadIdx.x; asm volatile("" : "+v"(tid_)); const int tid = tid_, wid = __builtin_amdgcn_readfirstlane(tid >> 6), lane = tid & 63, wr = wid >> 2, wc = wid & 3, fr = lane & 15, fq = lane >> 4;
    const int K = g.K, nt = K / BK;
    unsigned voffA[2], voffB[2];
#pragma unroll
    for (int i = 0; i < 2; ++i) { int R, C; stage_rc(tid * 16 + i * 8192, R, C); const int Rb = Epi::PERM ? ((R & ~31) + perm32(R & 31)) : R;
        voffA[i] = (unsigned)(R * K + C) * 2u; voffB[i] = (unsigned)(Rb * K + C) * 2u; }
    const size_t kstep = (size_t)(BK * 2);
    const size_t hstep = (size_t)HALF * K * 2;
    const size_t tstep = 2 * hstep;
    const unsigned ldsw = (unsigned)wid * 1024u;
    const int aoff = lds_byte(wr * 64 + fr, fq * 8), boff = lds_byte(wc * 32 + fr, fq * 8);
#define PG8_SA(b, h) (((b) * 2 + (h)) * HTB)
#define PG8_SB(b, h) ((4 + (b) * 2 + (h)) * HTB)
#define PG8_STAGE(bufoff, gbase, voff) do { _Pragma("unroll") for (int _i = 0; _i < 2; ++_i) \
        __builtin_amdgcn_global_load_lds((const unsigned*)((const char*)(gbase) + (voff)[_i]), (PG8_LAS unsigned*)(lds + (bufoff) + ldsw + _i * 8192), 16, 0, 0); } while (0)
#define PG8_LDA(dst, b, h) do { _Pragma("unroll") for (int m = 0; m < 4; ++m) _Pragma("unroll") for (int k = 0; k < 2; ++k) dst[m][k] = *(const PG8_LAS bf16x8*)(lds + PG8_SA(b, h) + aoff + m * 2048 + k * 1024); } while (0)
#define PG8_LDB(dst, b, h) do { _Pragma("unroll") for (int n = 0; n < 2; ++n) _Pragma("unroll") for (int k = 0; k < 2; ++k) dst[n][k] = *(const PG8_LAS bf16x8*)(lds + PG8_SB(b, h) + boff + n * 2048 + k * 1024); } while (0)
#define PG8_MMA(ai, bj, At, Bt) do { __builtin_amdgcn_s_setprio(1); _Pragma("unroll") for (int m = 0; m < 4; ++m) _Pragma("unroll") for (int n = 0; n < 2; ++n) _Pragma("unroll") for (int k = 0; k < 2; ++k) \
        acc[ai][bj][m][n] = __builtin_amdgcn_mfma_f32_16x16x32_bf16(Bt[n][k], At[m][k], acc[ai][bj][m][n], 0, 0, 0); __builtin_amdgcn_s_setprio(0); } while (0)
#define PG8_WAIT_V(n) asm volatile("s_waitcnt vmcnt(" #n ")" ::: "memory")
#define PG8_WAIT_L(n) asm volatile("s_waitcnt lgkmcnt(" #n ")" ::: "memory")
#define PG8_BAR __builtin_amdgcn_s_barrier()
#define PG8_SCHED __builtin_amdgcn_sched_barrier(0)
    Unit cur, nxt; int ui = 0;
    if (!S.next(0, cur)) return;
    f32x4 acc[2][2][4][2];
#pragma unroll
    for (int a = 0; a < 2; ++a)
#pragma unroll
        for (int b = 0; b < 2; ++b)
#pragma unroll
            for (int m = 0; m < 4; ++m)
#pragma unroll
                for (int n = 0; n < 2; ++n) acc[a][b][m][n] = (f32x4){0.f, 0.f, 0.f, 0.f};
    bf16x8 At[4][2], B0[2][2], B1[2][2];
    const char* cA = (const char*)g.A + (size_t)cur.pm * tstep; const char* cB = (const char*)g.Bt + (size_t)cur.pn * tstep;
    S.a_ready(cur);
    if constexpr (SP2) {
        PG8_STAGE(PG8_SB(0, 0), cB, voffB); PG8_STAGE(PG8_SB(0, 1), cB + hstep, voffB); PG8_STAGE(PG8_SA(0, 0), cA, voffA); PG8_STAGE(PG8_SA(0, 1), cA + hstep, voffA);
        if (wr == 1) PG8_BAR;
        PG8_WAIT_V(2); PG8_BAR;
        PG8_STAGE(PG8_SB(1, 0), cB + kstep, voffB); PG8_STAGE(PG8_SA(1, 0), cA + kstep, voffA); PG8_STAGE(PG8_SB(1, 1), cB + hstep + kstep, voffB);
        PG8_WAIT_V(6); PG8_BAR;
    } else {
        PG8_STAGE(PG8_SB(0, 0), cB, voffB); PG8_STAGE(PG8_SA(0, 0), cA, voffA); PG8_STAGE(PG8_SB(0, 1), cB + hstep, voffB); PG8_STAGE(PG8_SA(0, 1), cA + hstep, voffA);
        if (wr == 1) PG8_BAR;
        PG8_WAIT_V(4); PG8_BAR;
        PG8_STAGE(PG8_SB(1, 0), cB + kstep, voffB); PG8_STAGE(PG8_SA(1, 0), cA + kstep, voffA); PG8_STAGE(PG8_SB(1, 1), cB + hstep + kstep, voffB);
        PG8_WAIT_V(6); PG8_BAR;
    }
    for (;;) {
        const bool has_next = S.next(ui + 1, nxt);
        const char* nA = has_next ? (const char*)g.A + (size_t)nxt.pm * tstep : cA; const char* nB = has_next ? (const char*)g.Bt + (size_t)nxt.pn * tstep : cB;
        for (int t = 0; t < nt; t += 2) {
            const bool last = (t == nt - 2);
            const char* a1 = cA + (size_t)(t + 1) * kstep;
            const char* a2 = last ? nA : cA + (size_t)(t + 2) * kstep; const char* b2 = last ? nB : cB + (size_t)(t + 2) * kstep;
            const char* a3 = a2 + kstep; const char* b3 = b2 + kstep;
            if (last && has_next) S.a_ready(nxt);
            if constexpr (SP2) {
            PG8_LDB(B0, 0, 0); PG8_LDB(B1, 0, 1); PG8_SCHED; PG8_LDA(At, 0, 0); PG8_STAGE(PG8_SA(1, 1), a1 + hstep, voffA);
            PG8_WAIT_V(8); PG8_WAIT_L(0); PG8_BAR; PG8_MMA(0, 0, At, B0); PG8_MMA(0, 1, At, B1); PG8_BAR; PG8_SCHED;
            PG8_LDA(At, 0, 1); PG8_STAGE(PG8_SB(0, 0), b2, voffB); PG8_STAGE(PG8_SB(0, 1), b2 + hstep, voffB); PG8_STAGE(PG8_SA(0, 0), a2, voffA);
            PG8_WAIT_V(8); PG8_WAIT_L(0); PG8_BAR; PG8_MMA(1, 0, At, B0); PG8_MMA(1, 1, At, B1); PG8_BAR; PG8_SCHED;
            PG8_LDB(B0, 1, 0); PG8_LDB(B1, 1, 1); PG8_SCHED; PG8_LDA(At, 1, 0); PG8_STAGE(PG8_SA(0, 1), a2 + hstep, voffA);
            PG8_WAIT_V(8); PG8_WAIT_L(0); PG8_BAR; PG8_MMA(0, 0, At, B0); PG8_MMA(0, 1, At, B1); PG8_BAR; PG8_SCHED;
            PG8_LDA(At, 1, 1); PG8_STAGE(PG8_SB(1, 0), b3, voffB); PG8_STAGE(PG8_SB(1, 1), b3 + hstep, voffB); PG8_STAGE(PG8_SA(1, 0), a3, voffA);
            PG8_WAIT_V(8); PG8_WAIT_L(0); PG8_BAR; PG8_MMA(1, 0, At, B0); PG8_MMA(1, 1, At, B1); PG8_BAR; PG8_SCHED;
            } else {
            PG8_LDB(B0, 0, 0); PG8_SCHED; PG8_LDA(At, 0, 0); PG8_STAGE(PG8_SA(1, 1), a1 + hstep, voffA);
            PG8_WAIT_L(8); PG8_BAR; PG8_WAIT_L(0); PG8_MMA(0, 0, At, B0); PG8_BAR; PG8_SCHED;
            PG8_LDB(B1, 0, 1); PG8_STAGE(PG8_SB(0, 0), b2, voffB);
            PG8_BAR; PG8_WAIT_L(0); PG8_MMA(0, 1, At, B1); PG8_BAR;
            PG8_LDA(At, 0, 1); PG8_STAGE(PG8_SA(0, 0), a2, voffA);
            PG8_BAR; PG8_WAIT_L(0); PG8_MMA(1, 0, At, B0); PG8_BAR; PG8_SCHED;
            PG8_STAGE(PG8_SB(0, 1), b2 + hstep, voffB);
            PG8_WAIT_V(6); PG8_BAR; PG8_MMA(1, 1, At, B1); PG8_BAR;
            PG8_LDB(B0, 1, 0); PG8_SCHED; PG8_LDA(At, 1, 0); PG8_STAGE(PG8_SA(0, 1), a2 + hstep, voffA);
            PG8_WAIT_L(8); PG8_BAR; PG8_WAIT_L(0); PG8_MMA(0, 0, At, B0); PG8_BAR; PG8_SCHED;
            PG8_LDB(B1, 1, 1); PG8_STAGE(PG8_SB(1, 0), b3, voffB);
            PG8_BAR; PG8_WAIT_L(0); PG8_MMA(0, 1, At, B1); PG8_BAR;
            PG8_LDA(At, 1, 1); PG8_STAGE(PG8_SA(1, 0), a3, voffA);
            PG8_BAR; PG8_WAIT_L(0); PG8_MMA(1, 0, At, B0); PG8_BAR; PG8_SCHED;
            PG8_STAGE(PG8_SB(1, 1), b3 + hstep, voffB);
            PG8_WAIT_V(6); PG8_BAR; PG8_MMA(1, 1, At, B1); PG8_BAR;
            }
        }
        if constexpr (ALIGN_EPI) { if (wr == 0) PG8_BAR; }
        if constexpr (!Epi::AFTER_DRAIN) { E(acc, cur, wr, wc, fr, fq); S.done(cur); }
        if (!has_next) break;
#pragma unroll
        for (int a = 0; a < 2; ++a)
#pragma unroll
            for (int b = 0; b < 2; ++b)
#pragma unroll
                for (int m = 0; m < 4; ++m)
#pragma unroll
                    for (int n = 0; n < 2; ++n) acc[a][b][m][n] = (f32x4){0.f, 0.f, 0.f, 0.f};
        cur = nxt; cA = nA; cB = nB; ++ui;
        if constexpr (ALIGN_EPI) { if (wr == 1) PG8_BAR; }
    }
    PG8_WAIT_V(0);
    if constexpr (!ALIGN_EPI) { if (wr == 0) PG8_BAR; }
    PG8_BAR;
    if constexpr (Epi::AFTER_DRAIN) { E.fused(acc, cur, wr, wc, fr, fq, lds, wid, lane); S.done(cur); }
#undef PG8_SA
#undef PG8_SB
#undef PG8_STAGE
#undef PG8_LDA
#undef PG8_LDB
#undef PG8_MMA
#undef PG8_WAIT_V
#undef PG8_WAIT_L
#undef PG8_BAR
#undef PG8_SCHED
}
}
namespace attn_body {
using bf16=__hip_bfloat16;
using bf16x8=__attribute__((ext_vector_type(8)))short;
using s16x4=__attribute__((ext_vector_type(4)))short;
using f32x16=__attribute__((ext_vector_type(16)))float;
using f32x4=__attribute__((ext_vector_type(4)))float;
using u32x4=__attribute__((ext_vector_type(4)))unsigned;
constexpr int NHEAD=16,SEQ=8192,D=64,DM=NHEAD*D;
constexpr int NW=8,QBLK=32,QB=QBLK*NW,KVBLK=64,NQB=SEQ/QB;
constexpr float L2E=1.4426950408889634f;
__device__ __forceinline__ int crow(int r,int hi){return (r&3)+8*(r>>2)+4*hi;}
#define SBAR() __builtin_amdgcn_sched_barrier(0)
__device__ __forceinline__ void cmask(f32x16&p0,f32x16&p1,int jb,int qrel,int hi){
  const float NEG=-INFINITY; int kb=64*jb+4*hi;
  #pragma unroll
  for(int r=0;r<16;++r){int kv=kb+(r&3)+8*(r>>2); if(kv>qrel)p0[r]=NEG; if(kv+32>qrel)p1[r]=NEG;}
}
constexpr int NSLOT=3, SLOTB=8192;
constexpr int LDS_K=0, LDS_V=NSLOT*SLOTB, LDS_WS=2*NSLOT*SLOTB, LDS_OST=LDS_WS+NW*64*4, LDS_X=LDS_OST+NW*4096;
constexpr int LDS_VOTE=LDS_X+32768; constexpr int LDS_BYTES=LDS_VOTE+64;
constexpr float C2=0.125f*L2E;
__device__ __forceinline__ void glds16(const void*gsrc,unsigned lds_dst){unsigned keep;
  asm volatile("s_mov_b32 %0, m0\n\ts_mov_b32 m0, %2\n\ts_nop 0\n\tglobal_load_lds_dwordx4 %1, off\n\ts_mov_b32 m0, %0":"=&s"(keep):"v"(gsrc),"s"(lds_dst):"memory");}
__device__ __forceinline__ float max3f(float a,float b,float c){float r;asm("v_max3_f32 %0, %1, %2, %3":"=v"(r):"v"(a),"v"(b),"v"(c));return r;}
__device__ __forceinline__ float max2f(float a,float b){float r;asm("v_max_f32_e32 %0, %1, %2":"=v"(r):"v"(a),"v"(b));return r;}
__device__ __forceinline__ float fadd_s(float a,float b){float r;asm("v_add_f32_e32 %0, %1, %2":"=v"(r):"v"(a),"v"(b));return r;}
__device__ __forceinline__ float fsub_s(float a,float b){float r;asm("v_sub_f32_e32 %0, %1, %2":"=v"(r):"v"(a),"v"(b));return r;}
typedef float f32x2_t __attribute__((ext_vector_type(2))); typedef __bf16 bf16x2_t __attribute__((ext_vector_type(2)));
__device__ __forceinline__ unsigned cvtpk_s(float lo,float hi){f32x2_t v={lo,hi};bf16x2_t b=__builtin_convertvector(v,bf16x2_t);return __builtin_bit_cast(unsigned,b);}
#define WAIT_BAR(N) asm volatile("s_waitcnt vmcnt(" #N ") lgkmcnt(0)\n\ts_barrier":::"memory")
#define MF32(a,b,c) __builtin_amdgcn_mfma_f32_32x32x16_bf16(a,b,c,0,0,0)

__device__ __forceinline__ void qkt(f32x16&p0,f32x16&p1,const char*Kslot,const bf16x8*qr,int r32,int hi){
  const char*kb=Kslot+hi*1024+r32*16;
  #pragma unroll
  for(int d0=0;d0<4;++d0){
    const bf16x8 b0=*reinterpret_cast<const bf16x8*>(kb+d0*2048);
    const bf16x8 b1=*reinterpret_cast<const bf16x8*>(kb+d0*2048+512);
    p0=MF32(b0,qr[d0],p0);p1=MF32(b1,qr[d0],p1);}
}
typedef __attribute__((address_space(3))) const char* lds_cptr;
typedef short v4i16_t __attribute__((ext_vector_type(4)));
__device__ __forceinline__ void kload8(bf16x8*kf,lds_cptr kp){
  kf[0]=*(const __attribute__((address_space(3))) bf16x8*)(kp);      kf[1]=*(const __attribute__((address_space(3))) bf16x8*)(kp+512);
  kf[2]=*(const __attribute__((address_space(3))) bf16x8*)(kp+2048); kf[3]=*(const __attribute__((address_space(3))) bf16x8*)(kp+2560);
  kf[4]=*(const __attribute__((address_space(3))) bf16x8*)(kp+4096); kf[5]=*(const __attribute__((address_space(3))) bf16x8*)(kp+4608);
  kf[6]=*(const __attribute__((address_space(3))) bf16x8*)(kp+6144); kf[7]=*(const __attribute__((address_space(3))) bf16x8*)(kp+6656);
}
__device__ __forceinline__ void kload2(bf16x8*kf,lds_cptr kp,int j){ kf[2*j]=*(const __attribute__((address_space(3))) bf16x8*)(kp+j*2048); kf[2*j+1]=*(const __attribute__((address_space(3))) bf16x8*)(kp+j*2048+512); }
__device__ __forceinline__ s16x4 vtr(lds_cptr p){ return __builtin_bit_cast(s16x4,__builtin_amdgcn_ds_read_tr16_b64_v4i16((__attribute__((address_space(3))) v4i16_t*)p)); }
__device__ __forceinline__ float rowmax(const f32x16&p0,const f32x16&p1){
  float a=max3f(p0[0],p0[1],p1[0]),b=max3f(p0[2],p0[3],p1[1]);a=max3f(a,p1[2],p1[3]);
  #pragma unroll
  for(int r=4;r<16;r+=4){a=max3f(a,p0[r],p0[r+1]);b=max3f(b,p0[r+2],p0[r+3]);a=max3f(a,p1[r],p1[r+1]);b=max3f(b,p1[r+2],p1[r+3]);}
  const float m=max2f(a,b);
  auto rr=__builtin_amdgcn_permlane32_swap(__float_as_uint(m),__float_as_uint(m),false,false);
  return max2f(__uint_as_float(rr[0]),__uint_as_float(rr[1]));
}
__device__ __forceinline__ void pv(f32x16*o,int vb,bf16x8 pa0,bf16x8 pa1,bf16x8 pa2,bf16x8 pa3){
  #pragma unroll
  for(int d0=0;d0<2;++d0){s16x4 lo[4],hi[4];
    #pragma unroll
    for(int ks=0;ks<4;++ks){
      asm volatile("ds_read_b64_tr_b16 %0,%1 offset:%c2":"=&v"(lo[ks]):"v"(vb),"i"(d0*4096+ks*1024):"memory");
      asm volatile("ds_read_b64_tr_b16 %0,%1 offset:%c2":"=&v"(hi[ks]):"v"(vb),"i"(d0*4096+ks*1024+512):"memory");}
    asm volatile("s_waitcnt lgkmcnt(0)":::"memory");SBAR();
    #define PK(k) (bf16x8){lo[k][0],lo[k][1],lo[k][2],lo[k][3],hi[k][0],hi[k][1],hi[k][2],hi[k][3]}
    o[d0]=MF32(pa0,PK(0),o[d0]);
    o[d0]=MF32(pa1,PK(1),o[d0]);
    o[d0]=MF32(pa2,PK(2),o[d0]);
    o[d0]=MF32(pa3,PK(3),o[d0]);
    #undef PK
  }
}
__device__ __forceinline__ void split3(float v,unsigned&h,unsigned&m,unsigned&l){
  const unsigned u=__float_as_uint(v); h=u&0xffff0000u; const float r1=v-__uint_as_float(h); m=__float_as_uint(r1)&0xffff0000u; const float r2=r1-__uint_as_float(m); l=__float_as_uint(r2)&0xffff0000u; }
__device__ __forceinline__ bf16x8 kfeat(float v,int hi){ unsigned h,m,l; split3(v,h,m,l); u32x4 w; w.x=(h>>16)|m; w.y=(l>>16)|0x3f800000u; w.z=0x3f803f80u; w.w=0u; if(hi){w.x=0u;w.y=0u;w.z=0u;} return __builtin_bit_cast(bf16x8,w); }
__device__ __forceinline__ bf16x8 qfeat(float v,int hi){ unsigned h,m,l; split3(v,h,m,l); u32x4 w; w.x=0x3f803f80u; w.y=0x00003f80u|h; w.z=(m>>16)|l; w.w=0u; if(hi){w.x=0u;w.y=0u;w.z=0u;} return __builtin_bit_cast(bf16x8,w); }

#ifndef ATTN_STORE16
#define ATTN_STORE16(p,v) (*(u32x4*)(p)=(v))
#endif
template<int MODE,int THRL> __device__ __forceinline__ void attn_unit(int b,int h,int qb,const bf16*Q,const bf16*__restrict__ K,const bf16*__restrict__ V,bf16*O,char*shm,const float*__restrict__ cs2,const float*__restrict__ relb,float kmx){
  int tid_=threadIdx.x; asm volatile("":"+v"(tid_)); const int tid=tid_,lane=tid&63,r32=lane&31,hi=lane>>5; const int wid=__builtin_amdgcn_readfirstlane(tid>>6);
  const long rowbase=(long)b*SEQ; const int q0=qb*QB;
  const int t_lo=(MODE==1)?((4*qb-8)>0?(4*qb-8):0):0;
  const int NT=(q0+QB)/KVBLK-t_lo;
  const bf16*Qw=Q+(rowbase+q0+wid*QBLK)*DM+h*D;
  const bf16*Kh=K+(rowbase+(long)t_lo*KVBLK)*DM+h*D,*Vh=V+(rowbase+(long)t_lo*KVBLK)*DM+h*D;
  const unsigned lds0=(unsigned)(uintptr_t)shm;
  float*wsf=(float*)(shm+LDS_WS)+wid*64;
  const bf16*ksrc=Kh+(long)lane*DM+wid*8;
  const bf16*vsrc=Vh+(long)(16*(wid&3)+(lane>>2))*DM+(wid>>2)*32+(lane&3)*8;
  const unsigned kdst=lds0+LDS_K+wid*1024, vdst=lds0+LDS_V+wid*1024;
  #define TM(t) ((MODE==0)?(NT-1-(t)):(t))
  #define DMA_K(t,slot) glds16(ksrc+(long)TM(t)*KVBLK*DM,(unsigned)__builtin_amdgcn_readfirstlane(kdst+(slot)))
  #define DMA_V(t,slot) glds16(vsrc+(long)TM(t)*KVBLK*DM,(unsigned)__builtin_amdgcn_readfirstlane(vdst+(slot)))
  const int vb0=(int)(lds0+LDS_V)+((lane>>4)&1)*32+(lane&3)*8+(4*hi+((lane&15)>>2))*64;
  const char*Kbase=shm+LDS_K; bf16x8 kf[8];
  const lds_cptr shm3=(lds_cptr)shm; const lds_cptr kp0=shm3+LDS_K+hi*1024+r32*16; const lds_cptr vp0=shm3+LDS_V+((lane>>4)&1)*32+(lane&3)*8+(4*hi+((lane&15)>>2))*64;
  DMA_K(0,0);DMA_V(0,0);DMA_K(1,SLOTB);
  bf16x8 qr[4];
  #pragma unroll
  for(int d0=0;d0<4;++d0)qr[d0]=*reinterpret_cast<const bf16x8*>(&Qw[(long)r32*DM+d0*16+hi*8]);
  float ub=0.f;
  if constexpr(MODE==0){ float s2=0.f;
    #pragma unroll
    for(int d0=0;d0<4;++d0){
      #pragma unroll
      for(int j=0;j<8;++j){ const float f=__uint_as_float(((unsigned)(unsigned short)qr[d0][j])<<16); s2+=f*f; } }
    { auto rr=__builtin_amdgcn_permlane32_swap(__float_as_uint(s2),__float_as_uint(s2),false,false); s2=__uint_as_float(rr[0])+__uint_as_float(rr[1]); }
    ub=sqrtf(s2)*kmx; }
  volatile __attribute__((address_space(3))) unsigned*votes=(volatile __attribute__((address_space(3))) unsigned*)(shm3+LDS_VOTE);
  if constexpr(MODE==0){ const int nk=NT*KVBLK; for(int i=tid*4;i<nk;i+=NW*64*4) *(__attribute__((address_space(3))) f32x4*)(shm3+LDS_X+i*4)=*(const f32x4*)(cs2+i); }
  else { if(relb){ for(int i=tid;i<2560;i+=NW*64){ const int s=i/640,j=i-s*640; int idx=j+s; idx=idx>639?639:idx; int dist=575-idx; dist=dist>256?256:dist; dist=dist<-256?-256:dist;
           *(__attribute__((address_space(3))) float*)(shm3+LDS_X+s*2576+j*4)=L2E*relb[(dist+256)*16]; } } }
  float mhat=0.f,l_reg=0.f;f32x16 o[2];o[0]=f32x16{};o[1]=f32x16{};
  const f32x16 z16=f32x16{};
  bf16x8 qx=qfeat(0.f,hi); float cn0=0.f,cn1=0.f;
  const int qrel=wid*QBLK+r32;
  const int cw=wid>>1;
  const lds_cptr csl=shm3+LDS_X+r32*4;
  const int bsh=(3-r32)&3;
  const lds_cptr btab=shm3+LDS_X+bsh*2576+4*(64*t_lo+4*hi-(q0+qrel)+575-bsh);
  #define TVALID(t) (((t)<=NT-4+cw)&&((t)+12>=NT+cw))
  #define BUILDKX(tt) do{ if constexpr(MODE==0){ const float c0_=*(const __attribute__((address_space(3))) float*)(csl+TM(tt)*256), c1_=*(const __attribute__((address_space(3))) float*)(csl+TM(tt)*256+128); cn0=c0_; cn1=c1_; } }while(0)
  #define CINIT(C0,C1,t,val_) do{ if constexpr(MODE==0){ const bf16x8 kx0_=kfeat(-cn0,hi), kx1_=kfeat(-cn1,hi); C0=MF32(kx0_,qx,z16); C1=MF32(kx1_,qx,z16); } else { if(val_){ const lds_cptr bp_=btab+(t)*256; \
      _Pragma("unroll") for(int g_=0;g_<4;++g_){ const f32x4 a_=*(const __attribute__((address_space(3))) f32x4*)(bp_+g_*32), c_=*(const __attribute__((address_space(3))) f32x4*)(bp_+g_*32+128); \
        C0[4*g_]=a_[0]-mhat;C0[4*g_+1]=a_[1]-mhat;C0[4*g_+2]=a_[2]-mhat;C0[4*g_+3]=a_[3]-mhat; C1[4*g_]=c_[0]-mhat;C1[4*g_+1]=c_[1]-mhat;C1[4*g_+2]=c_[2]-mhat;C1[4*g_+3]=c_[3]-mhat; } } \
      else { C0=z16; C1=z16; } } }while(0)
  #define CMASK(P0,P1,t,val_,MK) do{ if constexpr(MODE==0){ int jb_=TM(t)-(NT-4); if(jb_>=0)cmask(P0,P1,jb_,qrel,hi); } else { if(!(val_)){ _Pragma("unroll") for(int r=0;r<16;++r){P0[r]=-INFINITY;P1[r]=-INFINITY;} } } }while(0)
  #define SETQX() do{ if constexpr(MODE==0){ qx=qfeat(-mhat,hi); } }while(0)
  bool resc=false;
  #define START(P0,P1) do{ const float rm=rowmax(P0,P1); resc=false; \
    { const float dl=(rm>-1e30f)?rm:0.f; mhat=fadd_s(mhat,dl); \
      _Pragma("unroll") for(int r=0;r<16;++r){P0[r]=fsub_s(P0[r],dl);P1[r]=fsub_s(P1[r],dl);} \
      SETQX(); } \
    _Pragma("unroll") for(int r=0;r<16;++r)P0[r]=__builtin_amdgcn_exp2f(P0[r]); }while(0)
  #define RESC() do{ if(resc){ asm volatile("s_waitcnt lgkmcnt(0)":::"memory"); \
      _Pragma("unroll") for(int d_=0;d_<2;++d_) _Pragma("unroll") for(int r=0;r<16;++r)o[d_][r]*=wsf[crow(r,hi)]; } }while(0)
  f32x16 pA0,pA1,pB0,pB1;
  int sl_prev=0,sl_cur=0,sl_next=SLOTB;
  #define ROT() do{sl_prev=sl_cur;sl_cur=sl_next;sl_next=(sl_next==(NSLOT-1)*SLOTB)?0:sl_next+SLOTB;}while(0)
  DMA_K(2,2*SLOTB);
  WAIT_BAR(3);
  BUILDKX(0);
  { const bool v0_=TVALID(0); CINIT(pA0,pA1,0,v0_);
    qkt(pA0,pA1,Kbase,qr,r32,hi);asm volatile("s_nop 15\n\ts_nop 7":"+v"(pA0),"+v"(pA1));CMASK(pA0,pA1,0,v0_,true); }
  START(pA0,pA1);
  _Pragma("unroll") for(int r=0;r<16;++r)pA1[r]=__builtin_amdgcn_exp2f(pA1[r]);
  WAIT_BAR(0);
  DMA_K(3,0);DMA_V(1,SLOTB);
  ROT();
  kload8(kf,kp0+sl_cur);
  BUILDKX(1);
  WAIT_BAR(2);
  s16x4 vlo[8],vhi[8]; u32x4 pw0,pw1,pw2,pw3;
  #define PKW(P,B) cvtpk_s(P[B],P[B+1])
  #define PAF(k) __builtin_bit_cast(bf16x8,pw##k)
  #define VFR(i) (bf16x8){vlo[i][0],vlo[i][1],vlo[i][2],vlo[i][3],vhi[i][0],vhi[i][1],vhi[i][2],vhi[i][3]}
  #define PIN(x) asm volatile("":"+v"(x))
  #define MX3(a,b,c) __builtin_fmaxf(__builtin_fmaxf((a),(b)),(c))
  #define GAPA(MF,A0,A1,A2,A3,W0,W1,PW) do{ MF; sacc+=A0; sacc+=A1; sacc+=A2; sacc+=A3; PIN(sacc); W0; W1; PIN(PW); SBAR(); }while(0)
  #define EX(v) __builtin_amdgcn_exp2f(v)
  #define GAPB(MF,X,B) do{ MF; X[B]=EX(X[B]); X[B+1]=EX(X[B+1]); X[B+2]=EX(X[B+2]); X[B+3]=EX(X[B+3]); PIN(X); SBAR(); }while(0)
  #define VRD(i) do{ vlo[i]=vtr(vp_+(((i)>>2)*4096+((i)&3)*1024)); vhi[i]=vtr(vp_+(((i)>>2)*4096+((i)&3)*1024+512)); }while(0)
  #define KRD(G,j) do{ if(G){ kload2(kf,kp0+sl_next,j); SBAR(); } }while(0)
  #define STEP(C0,C1,P0,P1,t,GK,GV,GL,MK) do{ SBAR(); \
    const lds_cptr vp_=vp0+sl_prev; const bool val_=TVALID(t); \
    CINIT(C0,C1,t,val_); SBAR(); \
    VRD(0); SBAR(); float sacc=(P0[0]+P0[1]); \
    GAPA(C0=MF32(kf[0],qr[0],C0), P0[2],P0[3],P0[4],P0[5],     pw0[0]=PKW(P0,0), pw0[1]=PKW(P0,2), pw0); \
    VRD(4); SBAR(); GAPA(C1=MF32(kf[1],qr[0],C1), P0[6],P0[7],P0[8],P0[9],     pw0[2]=PKW(P0,4), pw0[3]=PKW(P0,6), pw0); \
    VRD(1); SBAR(); GAPA(C0=MF32(kf[2],qr[1],C0),   P0[10],P0[11],P0[12],P0[13], pw1[0]=PKW(P0,8), pw1[1]=PKW(P0,10), pw1); \
    VRD(5); SBAR(); GAPA(C1=MF32(kf[3],qr[1],C1),   P0[14],P0[15],P1[0],P1[1],   pw1[2]=PKW(P0,12),pw1[3]=PKW(P0,14), pw1); \
    VRD(2); SBAR(); GAPA(C0=MF32(kf[4],qr[2],C0),   P1[2],P1[3],P1[4],P1[5],     pw2[0]=PKW(P1,0), pw2[1]=PKW(P1,2), pw2); \
    VRD(6); SBAR(); GAPA(C1=MF32(kf[5],qr[2],C1),   P1[6],P1[7],P1[8],P1[9],     pw2[2]=PKW(P1,4), pw2[3]=PKW(P1,6), pw2); \
    VRD(3); SBAR(); GAPA(C0=MF32(kf[6],qr[3],C0),   P1[10],P1[11],P1[12],P1[13], pw3[0]=PKW(P1,8), pw3[1]=PKW(P1,10), pw3); \
    VRD(7); SBAR(); GAPA(C1=MF32(kf[7],qr[3],C1),   P1[14],P1[15],0.f,0.f,       pw3[2]=PKW(P1,12),pw3[3]=PKW(P1,14), pw3); \
    l_reg+=sacc; \
    if(GK){DMA_K((t)+3,sl_cur);} if(GV){DMA_V((t)+1,sl_next);} \
    CMASK(C0,C1,t,val_,MK); \
    { float a=MX3(C0[0],C0[1],C1[0]),b=MX3(C0[2],C0[3],C1[1]); a=MX3(a,C1[2],C1[3]); \
      _Pragma("unroll") for(int r=4;r<16;r+=4){a=MX3(a,C0[r],C0[r+1]);b=MX3(b,C0[r+2],C0[r+3]);a=MX3(a,C1[r],C1[r+1]);b=MX3(b,C1[r+2],C1[r+3]);} \
      float rm=__builtin_fmaxf(a,b); { auto rr=__builtin_amdgcn_permlane32_swap(__float_as_uint(rm),__float_as_uint(rm),false,false); rm=__builtin_fmaxf(__uint_as_float(rr[0]),__uint_as_float(rr[1])); } \
      resc=false; \
      if(__builtin_expect(__any(rm>(float)THRL),0)){ const float dl=__builtin_fmaxf(rm,0.f); mhat+=dl; \
        _Pragma("unroll") for(int r=0;r<16;++r){C0[r]-=dl;C1[r]-=dl;} \
        SETQX(); \
        const float f=__builtin_amdgcn_exp2f(-dl); l_reg*=f; if(hi==0)wsf[r32]=f; resc=true; } } \
    SBAR(); \
    GAPB(o[0]=MF32(PAF(0),VFR(0),o[0]), C0,0); \
    GAPB(o[1]=MF32(PAF(0),VFR(4),o[1]), C0,4); \
    KRD(GL,0); GAPB(o[0]=MF32(PAF(1),VFR(1),o[0]), C0,8); \
    KRD(GL,1); GAPB(o[1]=MF32(PAF(1),VFR(5),o[1]), C0,12); \
    KRD(GL,2); GAPB(o[0]=MF32(PAF(2),VFR(2),o[0]), C1,0); \
    KRD(GL,3); GAPB(o[1]=MF32(PAF(2),VFR(6),o[1]), C1,4); \
    GAPB(o[0]=MF32(PAF(3),VFR(3),o[0]), C1,8); \
    GAPB(o[1]=MF32(PAF(3),VFR(7),o[1]), C1,12); \
    if(GL){ BUILDKX((t)+1); } \
    }while(0)
  int t=1; bool early=false;
  for(;t+5<NT;t+=2){
    STEP(pB0,pB1,pA0,pA1,t,true,true,true,false);     WAIT_BAR(2); RESC(); ROT();
    STEP(pA0,pA1,pB0,pB1,t+1,true,true,true,false);
    if constexpr(MODE==0){ if(t>=3){ const float Bn=-*(const __attribute__((address_space(3))) float*)(shm3+LDS_X+(64*(NT-3-t)+63)*4); const bool c_=(ub+Bn-mhat)<-160.f; const bool a_=__all(c_); if(lane==0)votes[wid]=a_?1u:0u; } }
    WAIT_BAR(2); RESC(); ROT();
    if constexpr(MODE==0){ if(t>=3){ const unsigned v_=votes[0]&votes[1]&votes[2]&votes[3]&votes[4]&votes[5]&votes[6]&votes[7]; if(__builtin_amdgcn_readfirstlane(v_)!=0u){ early=true; break; } } }
  }
  if(!early){
  #define ENDW(tt) do{ if((tt)+3<NT){WAIT_BAR(2);} else if((tt)+2<NT){WAIT_BAR(1);} else {WAIT_BAR(0);} }while(0)
  for(;t+1<NT;t+=2){
    STEP(pB0,pB1,pA0,pA1,t,(t+3<NT),(t+1<NT),(t+1<NT),true);       ENDW(t);   RESC(); ROT();
    STEP(pA0,pA1,pB0,pB1,t+1,(t+4<NT),(t+2<NT),(t+2<NT),true);     ENDW(t+1); RESC(); ROT();
  }
  STEP(pB0,pB1,pA0,pA1,NT-1,false,false,false,true); RESC();
  } else { pB0=pA0; pB1=pA1; }
  const int sl_d=early?sl_prev:sl_cur;
  { float sacc=pB0[0]+pB0[1]; _Pragma("unroll") for(int r=2;r<16;++r)sacc+=pB0[r]; _Pragma("unroll") for(int r=0;r<16;++r)sacc+=pB1[r]; l_reg+=sacc;
    pw0=(u32x4){PKW(pB0,0),PKW(pB0,2),PKW(pB0,4),PKW(pB0,6)};pw1=(u32x4){PKW(pB0,8),PKW(pB0,10),PKW(pB0,12),PKW(pB0,14)};pw2=(u32x4){PKW(pB1,0),PKW(pB1,2),PKW(pB1,4),PKW(pB1,6)};pw3=(u32x4){PKW(pB1,8),PKW(pB1,10),PKW(pB1,12),PKW(pB1,14)};
    SBAR(); pv(o,vb0+sl_d,PAF(0),PAF(1),PAF(2),PAF(3)); }
  if(early) asm volatile("s_waitcnt vmcnt(0)":::"memory");
  #undef PKW
  #undef PAF
  #undef VFR
  #undef PIN
  #undef MX3
  #undef GAPA
  #undef GAPB
  #undef EX
  #undef VRD
  #undef KRD
  #undef STEP
  #undef ENDW
  {auto rr=__builtin_amdgcn_permlane32_swap(__float_as_uint(l_reg),__float_as_uint(l_reg),false,false);l_reg=__uint_as_float(rr[0])+__uint_as_float(rr[1]);}
  if(hi==0)wsf[32+r32]=l_reg;asm volatile("s_waitcnt lgkmcnt(0)":::"memory");
  float rli[16];
  #pragma unroll
  for(int r=0;r<16;++r)rli[r]=__builtin_amdgcn_rcpf(wsf[32+crow(r,hi)]);
  bf16*Ow=O+(rowbase+q0+wid*QBLK)*DM+h*D;
  { bf16*stg=(bf16*)(shm+LDS_OST)+wid*2048;
    #pragma unroll
    for(int r=0;r<16;++r){const int orow=crow(r,hi);
      #pragma unroll
      for(int d0=0;d0<2;++d0)stg[orow*64+d0*32+r32]=__float2bfloat16(o[d0][r]*rli[r]);}
    asm volatile("s_waitcnt lgkmcnt(0)":::"memory");
    #pragma unroll
    for(int i=0;i<4;++i){const int row=i*8+(lane>>3),ch=lane&7; const u32x4 v=*(const u32x4*)(stg+row*64+ch*8); ATTN_STORE16(Ow+(long)row*DM+ch*8,v);} }
  asm volatile("s_waitcnt lgkmcnt(0)\n\ts_barrier":::"memory");
  #undef DMA_K
  #undef TM
  #undef DMA_V
  #undef CMASK
  #undef CINIT
  #undef BUILDKX
  #undef SETQX
  #undef TVALID
  #undef START
  #undef RESC
  #undef ROT
}
constexpr int ATTN_LDS_BYTES=LDS_BYTES;
#undef SBAR
#undef WAIT_BAR
#undef MF32
}
constexpr int NWAVES = 8;
#ifndef MK_N_LAUNCHES
#define MK_N_LAUNCHES 1
#endif
constexpr int N_PHASES = 18;
constexpr int DMODEL = 1024, NHEADS = 16, HDIM = 64, DFF = 4096, SEQL = 8192, NBATCH = 4, MP = NBATCH * SEQL, MS = 256, MTOT = MP + MS;
constexpr int PAST = 1024, WINC = 512, NREL = 513;
constexpr float L2E = 1.4426950408889634f;
constexpr size_t O_Y = 0, O_BKP = (size_t)MTOT * 1024, O_BVP = O_BKP + 4 * 512 * 1024, O_BKS = O_BVP + 4 * 512 * 1024, O_BVS = O_BKS + 262144,
                 O_FKP = O_BVS + 262144, O_FVP = O_FKP + (size_t)MP * 1024, O_FLP = O_FVP + (size_t)MP * 1024, O_FKS = O_FLP + (size_t)MP * 16, O_FVS = O_FKS + 262144, O_FLS = O_FVS + 262144, O_END = O_FLS + 4096;
constexpr size_t MiB = 1u << 20;
constexpr size_t WS_CTL = 0, CTL_ZERO_BYTES = 1 * MiB;
constexpr size_t WS_ROWSS = 1 * MiB;
constexpr size_t WS_BTOT = WS_ROWSS + 7 * (size_t)MTOT * 4;
constexpr size_t WS_CS2 = 2 * MiB;
constexpr size_t WS_W = 4 * MiB, W_LAYER = 57 * MiB;
constexpr size_t W_GUA = 0, W_DA = 16 * MiB, W_QKV = 24 * MiB, W_O = 31 * MiB, W_GUB = 33 * MiB, W_DB = 49 * MiB;
constexpr size_t WS_XG = 118 * MiB;
constexpr size_t WS_ACT = 183 * MiB;
constexpr size_t WS_QO = 183 * MiB, WS_KB = 248 * MiB, WS_VB = 313 * MiB;
constexpr size_t WS_OB = 441 * MiB;
constexpr size_t WS_END = 506 * MiB;
static_assert(WS_BTOT + 128 * 16 * 4 <= WS_CS2 && WS_ACT + (size_t)MTOT * 4096 * 2 <= WS_OB && WS_OB + (size_t)MTOT * 2048 <= WS_END && WS_XG + (size_t)MTOT * 2048 <= WS_ACT && WS_W + 2 * W_LAYER <= WS_XG, "ws map");
constexpr int CW_BAR = 4096, CW_QUEUE = 16384;
constexpr int RING_OFF = 0, RING_BYTES = 131072;
constexpr int LDSCTL_OFF = RING_BYTES, MISC_OFF = LDSCTL_OFF + 320;
constexpr int LDS_BYTES = 147456;
static_assert(attn_body::ATTN_LDS_BYTES + 64 <= RING_BYTES, "attention LDS");

#define GAS __attribute__((address_space(1)))
#define LAS __attribute__((address_space(3)))
typedef unsigned short bf16;
typedef unsigned v4u __attribute__((ext_vector_type(4)));
typedef float f32x4 __attribute__((ext_vector_type(4)));
typedef short bf16x8 __attribute__((ext_vector_type(8)));
typedef GAS unsigned gu32;
#define RLX_AGENT __ATOMIC_RELAXED, __HIP_MEMORY_SCOPE_AGENT
#define LDS_WAIT() asm volatile("s_waitcnt lgkmcnt(0)" ::: "memory")
#define VM_WAIT() asm volatile("s_waitcnt vmcnt(0)" ::: "memory")
__device__ __forceinline__ unsigned f2bf(float f) { unsigned u = __builtin_bit_cast(unsigned, f); return (u + 0x7fffu + ((u >> 16) & 1u)) >> 16; }
__device__ __forceinline__ unsigned pk2(float lo, float hi) { return f2bf(lo) | (f2bf(hi) << 16); }
__device__ __forceinline__ float bf2f(unsigned short b) { return __builtin_bit_cast(float, (unsigned)b << 16); }
struct QkvOff { static constexpr size_t o_qo = WS_QO, o_kb = WS_KB, o_vb = WS_VB, o_rowss0 = WS_ROWSS, o_btot = WS_BTOT, o_bkp = O_BKP, o_bvp = O_BVP, o_bks = O_BKS, o_bvs = O_BVS,
    o_fkp = O_FKP, o_fvp = O_FVP, o_fks = O_FKS, o_fvs = O_FVS, o_flp = O_FLP, o_fls = O_FLS; static constexpr int mtot = MTOT; };
#define XB_TMO      128
#define XB_XCNT(j)  (256  + 64 * (j))
#define XB_XSUB(j)  (1280 + 64 * (j))
#define XB_XGEN(j)  (2304 + 64 * (j))
#define XB_TOP      3328
#define XB_TOPGEN   3392
#define XCD_BAR_WORDS 3456
#define XB_SPIN_CAP (1u << 18)

__device__ __forceinline__ unsigned xb_ld(unsigned* p)              { return __hip_atomic_load(p, __ATOMIC_RELAXED, __HIP_MEMORY_SCOPE_AGENT); }
__device__ __forceinline__ unsigned xb_add(unsigned* p, unsigned v) { return __hip_atomic_fetch_add(p, v, __ATOMIC_RELAXED, __HIP_MEMORY_SCOPE_AGENT); }
__device__ __forceinline__ unsigned xb_xcc_id() { return (unsigned)__builtin_amdgcn_s_getreg((3 << 11) | 20) & 0xFu; }
#define XB_SPIN(cond, bar) do { unsigned _sp = 0; while (cond) { __builtin_amdgcn_s_sleep(1); \
    if ((++_sp & 255u) == 0u) { if (xb_ld(&(bar)[XB_TMO])) break; if (_sp > XB_SPIN_CAP) { atomicAdd(&(bar)[XB_TMO], 1u); break; } } } } while (0)

struct XcdBarrier {
    unsigned* bar; unsigned x;
    volatile LAS unsigned* st;
};

__device__ __forceinline__ XcdBarrier xcd_barrier_post(unsigned* bar, volatile LAS unsigned* st) {
    XcdBarrier b; b.bar = bar; b.x = xb_xcc_id(); b.st = st;
    if (threadIdx.x == 0) (void)xb_add(&bar[XB_XCNT(b.x)], 1u);
    return b;
}
__device__ __forceinline__ void xcd_barrier_complete(unsigned* bar, unsigned x, unsigned& nloc, unsigned& nx) {
    const unsigned G = gridDim.x * gridDim.y * gridDim.z;
    unsigned sum, cnt, mine, sp = 0u;
    for (;;) {
        sum = 0u; cnt = 0u; mine = 0u;
#pragma unroll
        for (unsigned j = 0; j < 16; ++j) { const unsigned c = xb_ld(&bar[XB_XCNT(j)]); sum += c; cnt += (c > 0u) ? 1u : 0u; mine = (j == x) ? c : mine; }
        if (sum == G) break;
        __builtin_amdgcn_s_sleep(1);
        if ((++sp & 255u) == 0u) { if (xb_ld(&bar[XB_TMO])) break; if (sp > XB_SPIN_CAP) { atomicAdd(&bar[XB_TMO], 1u); break; } }
    }
    nloc = mine > 0u ? mine : 1u; nx = cnt > 0u ? cnt : 1u;
}

__device__ __forceinline__ void xcd_barrier(const XcdBarrier& b) {
    asm volatile("s_waitcnt vmcnt(0)" ::: "memory");
    __syncthreads();
    if (threadIdx.x == 0) {
        unsigned* bar = b.bar;
        __builtin_amdgcn_s_waitcnt(0);
        unsigned nloc = b.st[0], nx = b.st[1];
        if (nloc == 0u) { xcd_barrier_complete(bar, b.x, nloc, nx); b.st[0] = nloc; b.st[1] = nx; }
        const unsigned old = xb_add(&bar[XB_XSUB(b.x)], 1u);
        const unsigned gen = old / nloc;
        if (old + 1u == (gen + 1u) * nloc) {
            __builtin_amdgcn_fence(__ATOMIC_RELEASE, "agent");
            asm volatile("s_waitcnt vmcnt(0)" ::: "memory");
            const unsigned og = xb_add(&bar[XB_TOP], 1u);
            const unsigned tg = og / nx;
            if (og + 1u == (tg + 1u) * nx) xb_add(&bar[XB_TOPGEN], 1u);
            else XB_SPIN(xb_ld(&bar[XB_TOPGEN]) == tg, bar);
            __builtin_amdgcn_fence(__ATOMIC_ACQUIRE, "agent");
            xb_add(&bar[XB_XGEN(b.x)], 1u);
            asm volatile("s_waitcnt vmcnt(0)" ::: "memory");
        } else {
            XB_SPIN(xb_ld(&bar[XB_XGEN(b.x)]) == gen, bar);
            __builtin_amdgcn_fence(__ATOMIC_ACQUIRE, "agent");
            asm volatile("s_waitcnt vmcnt(0)" ::: "memory");
        }
    }
    __syncthreads();
}

__device__ __forceinline__ float wave_sum(float v) {
#pragma unroll
    for (int o = 1; o < 64; o <<= 1) v += __shfl_xor(v, o);
    return v;
}
struct TrItem { const float* W; bf16* WT; const float* g; int K, N, mode, item; };
__device__ __forceinline__ void tr_load(const TrItem& t, int lane, f32x4 (&v)[8]) {
    const int nblk = t.N / 32, kb = t.item / nblk, nb = t.item % nblk, k0 = 64 * kb, n0 = 32 * nb;
#pragma unroll
    for (int i = 0; i < 8; ++i) { const int kk = 8 * i + (lane >> 3), n4 = (lane & 7) * 4; v[i] = *(const f32x4*)(t.W + (size_t)(k0 + kk) * t.N + n0 + n4); }
}
__device__ __forceinline__ void tr_finish(const TrItem& t, int lane, const f32x4 (&v)[8], LAS float* scr) {
    const int nblk = t.N / 32, kb = t.item / nblk, nb = t.item % nblk, k0 = 64 * kb, n0 = 32 * nb;
    const int drow = (t.mode == 0) ? n0 : ((n0 >> 7) * 256 + (n0 & 127) + (t.mode == 2 ? 128 : 0));
#pragma unroll
    for (int i = 0; i < 8; ++i) { const int kk = 8 * i + (lane >> 3), n4 = (lane & 7) * 4; const float gk = t.g ? t.g[k0 + kk] : 1.0f;
        scr[kk * 33 + n4] = v[i].x * gk; scr[kk * 33 + n4 + 1] = v[i].y * gk; scr[kk * 33 + n4 + 2] = v[i].z * gk; scr[kk * 33 + n4 + 3] = v[i].w * gk; }
    LDS_WAIT(); asm volatile("" ::: "memory");
    const int c = lane & 7;
#pragma unroll
    for (int j = 0; j < 4; ++j) { const int n = (lane >> 3) + 8 * j; const LAS float* s = scr + (8 * c) * 33 + n;
        v4u o; o.x = pk2(s[0 * 33], s[1 * 33]); o.y = pk2(s[2 * 33], s[3 * 33]); o.z = pk2(s[4 * 33], s[5 * 33]); o.w = pk2(s[6 * 33], s[7 * 33]);
        *(GAS v4u*)(t.WT + (size_t)(drow + n) * t.K + k0 + 8 * c) = o; }
    LDS_WAIT(); asm volatile("" ::: "memory");
}

struct Args { const float* in[17]; float* out; unsigned char* ws; int ph_lo, ph_hi, coop, pad; };
#define CAS __attribute__((address_space(4)))
typedef const float* const CAS* kin_t;
struct KA { kin_t in; float* out; unsigned char* ws; };
__device__ __forceinline__ KA get_ka() { const CAS char* kp = (const CAS char*)__builtin_amdgcn_kernarg_segment_ptr(); asm volatile("" : "+s"(kp));
    KA a; a.in = (kin_t)kp; a.out = *(float* const CAS*)((const CAS char*)kp + 136); a.ws = *(unsigned char* const CAS*)((const CAS char*)kp + 144); return a; }
static_assert(offsetof(Args, out) == 136 && offsetof(Args, ws) == 144, "Args layout");

__device__ __forceinline__ void p0_prologue(const KA& A, LAS unsigned char* lds, int gw, int NGW, int wave, int lane) {
    LAS float* scr = (LAS float*)(lds + wave * 16384);
    constexpr int I_G = 2048, I_D = 2048, I_Q = 1536, I_O = 512, PER_LAYER = 4 * I_G + 2 * I_D + I_Q + I_O;
    auto decode = [&](int it) -> TrItem { TrItem t; const int l = it / PER_LAYER; int r = it - l * PER_LAYER; unsigned char* wl = A.ws + WS_W + (size_t)l * W_LAYER;
        if (r < 4 * I_G) { const int w = r / I_G, j = w >> 1, up = w & 1; r -= w * I_G;
            t.W = A.in[up ? 11 : 10] + (size_t)(l * 2 + j) * 1024 * 4096; t.g = A.in[7] + (size_t)(3 * l + 2 * j) * 1024; t.K = 1024; t.N = 4096; t.WT = (bf16*)(wl + (j ? W_GUB : W_GUA)); t.mode = 1 + up; t.item = r; return t; }
        r -= 4 * I_G;
        if (r < 2 * I_D) { const int j = r / I_D; r -= j * I_D; t.W = A.in[12] + (size_t)(l * 2 + j) * 4096 * 1024; t.g = nullptr; t.K = 4096; t.N = 1024; t.WT = (bf16*)(wl + (j ? W_DB : W_DA)); t.mode = 0; t.item = r; return t; }
        r -= 2 * I_D;
        if (r < I_Q) { t.W = A.in[8] + (size_t)l * 1024 * 3072; t.g = A.in[7] + (size_t)(3 * l + 1) * 1024; t.K = 1024; t.N = 3072; t.WT = (bf16*)(wl + W_QKV); t.mode = 0; t.item = r; return t; }
        r -= I_Q; t.W = A.in[9] + (size_t)l * 1024 * 1024; t.g = nullptr; t.K = 1024; t.N = 1024; t.WT = (bf16*)(wl + W_O); t.mode = 0; t.item = r; return t; };
    for (int it = gw; it < 2 * PER_LAYER; it += 2 * NGW) {
        const bool two = it + NGW < 2 * PER_LAYER;
        const TrItem t0 = decode(it), t1 = decode(two ? it + NGW : it);
        f32x4 v0[8], v1[8]; tr_load(t0, lane, v0); if (two) tr_load(t1, lane, v1);
        tr_finish(t0, lane, v0, scr); if (two) tr_finish(t1, lane, v1, scr);
    }
    { bf16* wq1 = (bf16*)(A.ws + WS_W + W_LAYER + W_QKV) + (size_t)3072 * 1024; const float* wf = A.in[14];
      for (int i = gw * 64 + lane; i < 256 * 1024; i += NGW * 64) { const int n = i >> 10, k = i & 1023; wq1[i] = (n < 16) ? (bf16)f2bf(wf[k * 16 + n] * A.in[7][4 * 1024 + k]) : (bf16)0; } }
    float* rowss = (float*)(A.ws + WS_ROWSS); float* x = A.out; bf16* xg = (bf16*)(A.ws + WS_XG); const float* g0 = A.in[7];
    f32x4 gv[4];
#pragma unroll
    for (int j = 0; j < 4; ++j) gv[j] = *(const f32x4*)(g0 + 4 * lane + 256 * j);
    for (int m0 = gw; m0 < MTOT; m0 += 2 * NGW) {
        f32x4 v[2][4]; const bool two = m0 + NGW < MTOT;
#pragma unroll
        for (int q = 0; q < 2; ++q) { const int m = (q && two) ? m0 + NGW : m0; const float* src = (m < MP) ? A.in[0] + (size_t)m * 1024 : A.in[1] + (size_t)(m - MP) * 1024;
#pragma unroll
            for (int j = 0; j < 4; ++j) v[q][j] = *(const f32x4*)(src + 4 * lane + 256 * j); }
#pragma unroll
        for (int q = 0; q < 2; ++q) { if (q && !two) break; const int m = q ? m0 + NGW : m0; float s = 0.f;
#pragma unroll
            for (int j = 0; j < 4; ++j) s += (v[q][j].x * v[q][j].x + v[q][j].y * v[q][j].y) + (v[q][j].z * v[q][j].z + v[q][j].w * v[q][j].w);
            s = wave_sum(s);
#pragma unroll
            for (int j = 0; j < 4; ++j) { const f32x4 a = v[q][j];
                *(unsigned long long*)(xg + (size_t)m * 1024 + 4 * lane + 256 * j) = (unsigned long long)pk2(a.x, a.y) | ((unsigned long long)pk2(a.z, a.w) << 32); }
            if (lane == 0) rowss[m] = s; }
    }
    for (int i = gw * 64 + lane; i < 6 * MTOT + 128 * 16 + 64; i += NGW * 64) rowss[MTOT + i] = 0.f;
}


typedef float f32x4s __attribute__((ext_vector_type(4)));
template <int NB> __device__ __forceinline__ void skinny_mma(const bf16* A, const bf16* B0, const bf16* B1, int K, int wave, int lane, LAS unsigned char* lds, f32x4s (&acc)[NB]) {
    const int fr = lane & 15, fq = lane >> 4, rf = wave & 3, kh = wave >> 2, KH = K >> 1;
    const bf16* ap = A + (size_t)(16 * rf + fr) * K + kh * KH + 8 * fq;
    const bf16* bp0 = B0 + (size_t)fr * K + kh * KH + 8 * fq; const bf16* bp1 = (NB == 2) ? B1 + (size_t)fr * K + kh * KH + 8 * fq : bp0;
#pragma unroll
    for (int nb = 0; nb < NB; ++nb) acc[nb] = (f32x4s){0.f, 0.f, 0.f, 0.f};
    constexpr int U = 16;
#pragma unroll 1
    for (int k0 = 0; k0 < KH; k0 += 32 * U) { bf16x8 av[U], bv[U][NB];
#pragma unroll
        for (int s = 0; s < U; ++s) { av[s] = *(const bf16x8*)(ap + k0 + 32 * s); bv[s][0] = *(const bf16x8*)(bp0 + k0 + 32 * s); if (NB == 2) bv[s][1] = *(const bf16x8*)(bp1 + k0 + 32 * s); }
#pragma unroll
        for (int s = 0; s < U; ++s)
#pragma unroll
            for (int nb = 0; nb < NB; ++nb) acc[nb] = __builtin_amdgcn_mfma_f32_16x16x32_bf16(av[s], bv[s][nb], acc[nb], 0, 0, 0); }
    LAS f32x4s* red = (LAS f32x4s*)lds;
    if (kh == 1) {
#pragma unroll
        for (int nb = 0; nb < NB; ++nb) red[(rf * 64 + lane) * NB + nb] = acc[nb]; }
    __syncthreads();
    if (kh == 0) {
#pragma unroll
        for (int nb = 0; nb < NB; ++nb) acc[nb] += red[(rf * 64 + lane) * NB + nb]; }
    __syncthreads();
}
template <int NB, int NRF> __device__ __forceinline__ void skinny_full(const bf16* A, const bf16* B0, const bf16* B1, int K, int wave, int lane, f32x4s (&acc)[NB][NRF]) {
    const int fr = lane & 15, fq = lane >> 4;
    const bf16* ap = A + (size_t)(16 * NRF * wave + fr) * K + 8 * fq;
    const bf16* bp0 = B0 + (size_t)fr * K + 8 * fq; const bf16* bp1 = (NB == 2) ? B1 + (size_t)fr * K + 8 * fq : bp0;
#pragma unroll
    for (int nb = 0; nb < NB; ++nb)
#pragma unroll
        for (int a = 0; a < NRF; ++a) acc[nb][a] = (f32x4s){0.f, 0.f, 0.f, 0.f};
    constexpr int U = 8;
#pragma unroll 1
    for (int k0 = 0; k0 < K; k0 += 32 * U) { bf16x8 av[U][NRF], bv[U][NB];
#pragma unroll
        for (int s = 0; s < U; ++s) {
#pragma unroll
            for (int a = 0; a < NRF; ++a) av[s][a] = *(const bf16x8*)(ap + (size_t)(16 * a) * K + k0 + 32 * s);
            bv[s][0] = *(const bf16x8*)(bp0 + k0 + 32 * s); if (NB == 2) bv[s][1] = *(const bf16x8*)(bp1 + k0 + 32 * s); }
#pragma unroll
        for (int s = 0; s < U; ++s)
#pragma unroll
            for (int nb = 0; nb < NB; ++nb)
#pragma unroll
                for (int a = 0; a < NRF; ++a) acc[nb][a] = __builtin_amdgcn_mfma_f32_16x16x32_bf16(av[s][a], bv[s][nb], acc[nb][a], 0, 0, 0); }
}
__device__ __forceinline__ void skinny_gateup(const KA& A, LAS unsigned char* lds, int G, int bx, int wave, int lane, const bf16* Wgu, const float* rowss) {
    const bf16* XG = (const bf16*)(A.ws + WS_XG) + (size_t)MP * 1024; bf16* ACT = (bf16*)(A.ws + WS_ACT);
    const int fr = lane & 15, fq = lane >> 4;
    for (int sl = bx; sl < 256; sl += G) { const int c0 = 16 * sl; const int brow = (c0 >> 7) * 256 + (c0 & 127);
        f32x4s acc[2][2]; skinny_full<2, 2>(XG, Wgu + (size_t)brow * 1024, Wgu + (size_t)(brow + 128) * 1024, 1024, wave, lane, acc);
#pragma unroll
        for (int a = 0; a < 2; ++a)
#pragma unroll
            for (int i = 0; i < 4; ++i) { const int row = MP + 16 * (2 * wave + a) + 4 * fq + i; const float rs = pg8::rstd_of(rowss[row]);
                ACT[(size_t)row * 4096 + c0 + fr] = (bf16)f2bf(pg8::silu_mul(acc[0][a][i] * rs, acc[1][a][i] * rs)); } }
}
__device__ __forceinline__ void skinny_resid(const KA& A, const float* xin32  , LAS unsigned char* lds, int G, int bx, int wave, int lane, const bf16* Ain, int K, const bf16* Wt, bf16* xb, float* rowss_next, float alpha) {
    const int fr = lane & 15, fq = lane >> 4, rf = wave & 3;
    for (int it = bx; it < 256; it += G) { const int sl = it >> 2, rg = it & 3, c0 = 16 * sl;
        f32x4s acc[1]; skinny_mma<1>(Ain + (size_t)(MP + 64 * rg) * K, Wt + (size_t)c0 * K, nullptr, K, wave, lane, lds, acc);
        if (wave < 4) {
#pragma unroll
            for (int i = 0; i < 4; ++i) { const int row = MP + 64 * rg + 16 * rf + 4 * fq + i; const size_t o = (size_t)row * 1024 + c0 + fr;
                const float v = (xin32 ? xin32[o] : bf2f(xb[o])) + alpha * acc[0][i]; xb[o] = (bf16)f2bf(v);
                float ss = v * v; ss += __shfl_xor(ss, 1); ss += __shfl_xor(ss, 2); ss += __shfl_xor(ss, 4); ss += __shfl_xor(ss, 8);
                if (fr == 0) __hip_atomic_fetch_add(rowss_next + row, ss, __ATOMIC_RELAXED, __HIP_MEMORY_SCOPE_AGENT); } } }
}
__device__ __forceinline__ void skinny_qkv(const KA& A, LAS unsigned char* lds, int G, int bx, int wave, int lane, const bf16* Wqkv, const float* rowss, int fox) {
    const bf16* XG = (const bf16*)(A.ws + WS_XG) + (size_t)MP * 1024;
    const int fr = lane & 15, fq = lane >> 4;
    for (int sl = bx; sl < 192; sl += G) { const int c0 = 16 * sl;
        f32x4s acc[1][2]; skinny_full<1, 2>(XG, Wqkv + (size_t)c0 * 1024, nullptr, 1024, wave, lane, acc);
        const int t = sl >> 6, cin = c0 - 1024 * t + fr; bf16* bd = (bf16*)(A.ws + (t == 0 ? WS_QO : t == 1 ? WS_KB : WS_VB));
#pragma unroll
        for (int a = 0; a < 2; ++a)
#pragma unroll
            for (int i = 0; i < 4; ++i) { const int rl = 16 * (2 * wave + a) + 4 * fq + i, row = MP + rl; const float v = acc[0][a][i] * pg8::rstd_of(rowss[row]);
                bd[(size_t)row * 1024 + cin] = (bf16)f2bf(t == 0 ? v * attn_body::C2 : v);
                if (t == 1) A.out[(fox ? O_FKS : O_BKS) + (size_t)rl * 1024 + cin] = v; else if (t == 2) A.out[(fox ? O_FVS : O_BVS) + (size_t)rl * 1024 + cin] = v; } }
}
__device__ __forceinline__ void skinny_logf(const KA& A, LAS unsigned char* lds, int G, int bx, int wave, int lane, const bf16* Wf  , const float* rowss) {
    const bf16* XG = (const bf16*)(A.ws + WS_XG); float* blocktot = (float*)(A.ws + WS_BTOT);
    const int fr = lane & 15, fq = lane >> 4; const float bfr = A.in[15][fr];
    for (int it = bx; it < MTOT / 128; it += G) {
        f32x4s acc[1][1]; skinny_full<1, 1>(XG + (size_t)(128 * it) * 1024, Wf, nullptr, 1024, wave, lane, acc);
        float tot = 0.f;
#pragma unroll
        for (int i = 0; i < 4; ++i) { const int row = 128 * it + 16 * wave + 4 * fq + i; const float z = acc[0][0][i] * pg8::rstd_of(rowss[row]) + bfr; const float ee = __builtin_amdgcn_exp2f(-L2E * fabsf(z));
            const float big = 0.6931471805599453f * __builtin_amdgcn_logf(1.0f + ee), sm = ee * (1.0f - ee * (0.5f - ee * (0.3333333333f - 0.25f * ee)));
            const float lfv = fminf(z, 0.f) - (ee < 0.03f ? sm : big); tot += lfv;
            if (row < MP) A.out[O_FLP + (size_t)row * 16 + fr] = lfv; else A.out[O_FLS + (size_t)(row - MP) * 16 + fr] = lfv; }
        tot += __shfl_xor(tot, 16); tot += __shfl_xor(tot, 32);
        if (fq == 0 && it < MP / 128) __hip_atomic_fetch_add(blocktot + (it >> 1) * 16 + fr, tot, __ATOMIC_RELAXED, __HIP_MEMORY_SCOPE_AGENT); }
}
template <int FOX> __device__ __forceinline__ void sample_unit(int s, int h, LAS unsigned char* lds, const KA& A) {
    constexpr int NC = FOX ? 1024 : 512, NK = NC + 16, SP = 1056;
    int tid_ = threadIdx.x; asm volatile("" : "+v"(tid_)); const int tid = tid_, lane = tid & 63, wave = tid >> 6;
    LAS float* Qs = (LAS float*)lds;
    LAS float* cum = (LAS float*)(lds + 4096);
    LAS float* linv = (LAS float*)(lds + 8320);
    LAS float* S = (LAS float*)(lds + 8448);
    bf16* QO = (bf16*)(A.ws + WS_QO);
    const float* ck = A.in[FOX ? 4 : 2]; const float* cv = A.in[FOX ? 5 : 3];
    const float* nk = A.out + (FOX ? O_FKS : O_BKS); const float* nv = A.out + (FOX ? O_FVS : O_BVS);
    { const int e = tid * 2, i = e >> 6, d = e & 63; const unsigned w = *(const unsigned*)(QO + (size_t)(MP + s * 16 + i) * 1024 + h * 64 + d);
      Qs[i * 64 + d] = bf2f((unsigned short)(w & 0xffffu)); Qs[i * 64 + d + 1] = bf2f((unsigned short)(w >> 16)); }
    if (FOX && wave == 0) { const float* clf = A.in[6]; const float* nlf = A.out + O_FLS; float carry = 0.f;
        for (int c = 0; c < 17; ++c) { const int j = c * 64 + lane;
            float v = (j < 1024) ? clf[(size_t)(s * 1024 + j) * 16 + h] : ((j < 1040) ? nlf[(size_t)(s * 16 + j - 1024) * 16 + h] : 0.f);
#pragma unroll
            for (int d = 1; d < 64; d <<= 1) { const float t = __shfl_up(v, d); if (lane >= d) v += t; }
            v += carry; if (j < 1040) cum[j] = v; carry = __shfl(v, 63); } }
    __syncthreads();
    const float* relb = A.in[13] + h;
    for (int j = tid; j < NK; j += 512) {
        const float* kp = (j < NC) ? ck + ((size_t)(s * NC + j) * 16 + h) * 64 : nk + (size_t)(s * 16 + j - NC) * 1024 + h * 64;
        f32x4 kr[16];
#pragma unroll
        for (int q = 0; q < 16; ++q) kr[q] = *(const f32x4*)(kp + 4 * q);
        const float cj = FOX ? cum[j] : 0.f;
#pragma unroll 1
        for (int i = 0; i < 16; ++i) { float a = 0.f;
#pragma unroll
            for (int q = 0; q < 16; ++q) { const f32x4 qv = *(const LAS f32x4*)(Qs + i * 64 + 4 * q); a += (qv.x * kr[q].x + qv.y * kr[q].y) + (qv.z * kr[q].z + qv.w * kr[q].w); }
            float bias; bool valid = true;
            if (FOX) { bias = L2E * (cum[NC + i] - cj); valid = (j <= NC + i); }
            else { int dist = 512 + i - j; dist = dist > 256 ? 256 : dist; dist = dist < -256 ? -256 : dist; bias = L2E * relb[(dist + 256) * 16]; }
            S[i * SP + j] = valid ? a + bias : -INFINITY; }
    }
    __syncthreads();
#pragma unroll 1
    for (int rr = 0; rr < 2; ++rr) { const int i = wave * 2 + rr; float m = -INFINITY;
        for (int j = lane; j < NK; j += 64) m = fmaxf(m, S[i * SP + j]);
#pragma unroll
        for (int o = 1; o < 64; o <<= 1) m = fmaxf(m, __shfl_xor(m, o));
        float l = 0.f;
        for (int j = lane; j < NK; j += 64) { const float p = __builtin_amdgcn_exp2f(S[i * SP + j] - m); S[i * SP + j] = p; l += p; }
        l = wave_sum(l); if (lane == 0) linv[i] = 1.0f / l; }
    __syncthreads();
    {
      LAS float* red = (LAS float*)(lds + 8448 + 16 * SP * 4);
      float o[16];
#pragma unroll
      for (int i = 0; i < 16; ++i) o[i] = 0.f;
#pragma unroll 8
      for (int j = wave; j < NK; j += 8) { const float v = (j < NC) ? cv[((size_t)(s * NC + j) * 16 + h) * 64 + lane] : nv[(size_t)(s * 16 + j - NC) * 1024 + h * 64 + lane];
#pragma unroll
          for (int i = 0; i < 16; ++i) o[i] += S[i * SP + j] * v; }
#pragma unroll
      for (int i = 0; i < 16; ++i) red[(wave * 16 + i) * 64 + lane] = o[i];
      __syncthreads();
#pragma unroll
      for (int rr = 0; rr < 2; ++rr) { const int i = wave * 2 + rr; float a = 0.f;
#pragma unroll
          for (int w = 0; w < 8; ++w) a += red[(w * 16 + i) * 64 + lane];
          ((bf16*)(A.ws + WS_OB))[(size_t)(MP + s * 16 + i) * 1024 + h * 64 + lane] = (bf16)f2bf(a * linv[i]); } }
    __syncthreads();
}

__device__ __forceinline__ void cumsum_phase(const KA& A, LAS unsigned char* lds, int G) {
    int tid_ = threadIdx.x; asm volatile("" : "+v"(tid_)); const int tid = tid_, h = tid & 15, j = tid >> 4;
    LAS float* tot = (LAS float*)lds;
    const float* lf = A.out + O_FLP; const float* bt = (const float*)(A.ws + WS_BTOT); float* cs2 = (float*)(A.ws + WS_CS2);
    {
        const bf16* KBp = (const bf16*)(A.ws + WS_KB); unsigned* kmax2 = (unsigned*)(A.ws + WS_BTOT) + 2048;
        const int lane = tid & 63, gw = blockIdx.x * NWAVES + (tid >> 6), NGW = G * NWAVES, b = gw & 3; float mx = 0.f;
#pragma unroll 4
        for (int r = gw >> 2; r < SEQL; r += (NGW >> 2)) { const bf16* kr = KBp + (size_t)(b * SEQL + r) * 1024 + 16 * lane; const bf16x8 v0 = *(const bf16x8*)kr, v1 = *(const bf16x8*)(kr + 8); float s2 = 0.f;
#pragma unroll
            for (int j = 0; j < 8; ++j) { const float f0 = bf2f((unsigned short)v0[j]), f1 = bf2f((unsigned short)v1[j]); s2 += f0 * f0 + f1 * f1; }
            s2 += __shfl_xor(s2, 1); s2 += __shfl_xor(s2, 2); mx = fmaxf(mx, s2); }
        if ((lane & 3) == 0) __hip_atomic_fetch_max(kmax2 + b * 16 + (lane >> 2), __float_as_uint(mx), __ATOMIC_RELAXED, __HIP_MEMORY_SCOPE_AGENT);
    }
    for (int it = blockIdx.x; it < 128; it += G) { const int b = it >> 5, seg = it & 31;
        float base = 0.f; for (int s2 = 0; s2 < seg; ++s2) base += bt[(b * 32 + s2) * 16 + h];
        const int t0 = seg * 256 + j * 8; float p[8]; float run = 0.f;
#pragma unroll
        for (int i = 0; i < 8; ++i) { run += lf[(size_t)(b * 8192 + t0 + i) * 16 + h]; p[i] = run; }
        tot[j * 16 + h] = run; __syncthreads();
        float off = base; for (int j2 = 0; j2 < j; ++j2) off += tot[j2 * 16 + h];
        float* dst = cs2 + (size_t)(b * 16 + h) * 8192 + t0;
        *(f32x4*)dst = (f32x4){L2E * (off + p[0]), L2E * (off + p[1]), L2E * (off + p[2]), L2E * (off + p[3])};
        *(f32x4*)(dst + 4) = (f32x4){L2E * (off + p[4]), L2E * (off + p[5]), L2E * (off + p[6]), L2E * (off + p[7])};
        __syncthreads(); }
}

__global__ void __launch_bounds__(NWAVES * 64, 2) mk_fwd(Args args) {
    extern __shared__ __attribute__((aligned(16))) unsigned char lds[];
    LAS unsigned char* lds3 = (LAS unsigned char*)lds;
    volatile LAS unsigned* MISC = (volatile LAS unsigned*)(lds3 + MISC_OFF);
    const int tid0 = threadIdx.x;
    gu32* ctl = (gu32*)(args.ws + WS_CTL);
    for (int u = tid0; u < (LDS_BYTES - LDSCTL_OFF) / 4; u += NWAVES * 64) ((LAS unsigned*)(lds3 + LDSCTL_OFF))[u] = 0u;
    __syncthreads();
    XcdBarrier bar; bar.bar = (unsigned*)(ctl + CW_BAR); bar.x = 0; bar.st = nullptr;
    if (args.coop) bar = xcd_barrier_post((unsigned*)(ctl + CW_BAR), MISC + 8);

    int rep = 0;
    for (int p = args.ph_lo; p < args.ph_hi; ++p) {
        bool did = true;
        const KA A = get_ka();
        int tid_ = threadIdx.x; asm volatile("" : "+v"(tid_)); const int tid = tid_, lane = tid & 63, wave = __builtin_amdgcn_readfirstlane(tid >> 6);
        int G_ = gridDim.x, bx_ = blockIdx.x; asm volatile("" : "+s"(G_), "+s"(bx_)); const int G = G_, bx = bx_; const int vcu = (G % 8 == 0) ? (bx % 8) * (G / 8) + bx / 8 : bx;
        unsigned char* ws = A.ws;
        float* rowss = (float*)(ws + WS_ROWSS);
        bf16* XG = (bf16*)(ws + WS_XG); bf16* ACT = (bf16*)(ws + WS_ACT); bf16* QO = (bf16*)(ws + WS_QO); bf16* KB = (bf16*)(ws + WS_KB); bf16* VB = (bf16*)(ws + WS_VB);
        if (p == 0) {
#ifndef NO_P0
 p0_prologue(A, lds3, vcu * NWAVES + wave, G * NWAVES, wave, lane);
#endif
 }
        else if (p == N_PHASES - 1) {
            const float* gf = A.in[16]; f32x4 gv[4];
#pragma unroll
            for (int j = 0; j < 4; ++j) gv[j] = *(const f32x4*)(gf + 4 * lane + 256 * j);
            for (int m = vcu * NWAVES + wave; m < MTOT; m += G * NWAVES) { const float rs = pg8::rstd_of(rowss[6 * MTOT + m]); float* yr = A.out + (size_t)m * 1024 + 4 * lane; const bf16* xr = XG + (size_t)m * 1024 + 4 * lane;
#pragma unroll
                for (int j = 0; j < 4; ++j) { const unsigned long long w = *(const unsigned long long*)(xr + 256 * j);
                    const f32x4 v = {bf2f((unsigned short)(w & 0xffffu)), bf2f((unsigned short)((w >> 16) & 0xffffu)), bf2f((unsigned short)((w >> 32) & 0xffffu)), bf2f((unsigned short)(w >> 48))};
                    *(f32x4*)(yr + 256 * j) = v * rs * gv[j]; } }
        } else {
            const int l = (p - 1) >> 3, k = (p - 1) & 7;
            unsigned char* wl = ws + WS_W + (size_t)l * W_LAYER;
            if (k == 0 || k == 6) {
                pg8::Gemm g{XG, (const bf16*)(wl + (k ? W_GUB : W_GUA)), MP, 2 * DFF, DMODEL}; pg8::StaticOrder S; S.init(MP, 2 * DFF, G, bx);
                pg8::EpiGateUp E{ACT, rowss + (size_t)(3 * l + (k ? 2 : 0)) * MTOT};

#ifndef NO_GU
pg8::gemm_phase<pg8::EpiGateUp, pg8::StaticOrder, true, true>(lds3 + RING_OFF, g, S, E);
#endif
                skinny_gateup(A, lds3 + RING_OFF, G, bx, wave, lane, (const bf16*)(wl + (k ? W_GUB : W_GUA)), rowss + (size_t)(3 * l + (k ? 2 : 0)) * MTOT);
#ifdef PROBE_SKINNY
                for (int rp_ = 0; rp_ < 4; ++rp_) skinny_gateup(A, lds3 + RING_OFF, G, bx, wave, lane, (const bf16*)(wl + (k ? W_GUB : W_GUA)), rowss + (size_t)(3 * l + (k ? 2 : 0)) * MTOT);
#endif

            } else if (k == 1 || k == 7 || k == 5) {
                const int nn = (k == 1) ? 3 * l + 1 : (k == 5) ? 3 * l + 2 : 3 * l + 3;
                pg8::Gemm g{(k == 5) ? (const bf16*)(ws + WS_OB) : ACT, (const bf16*)(wl + ((k == 1) ? W_DA : (k == 7) ? W_DB : W_O)), MP, DMODEL, (k == 5) ? DMODEL : DFF}; pg8::StaticOrder S; S.init(MP, DMODEL, G, bx);
                { pg8::EpiResid<false> E{nullptr, XG, rowss + (size_t)nn * MTOT, (k == 5) ? 1.0f : 0.5f};
#ifndef NO_RES
                    pg8::gemm_phase<pg8::EpiResid<false>, pg8::StaticOrder, true, true>(lds3 + RING_OFF, g, S, E);
#endif
                }
                skinny_resid(A, nullptr, lds3 + RING_OFF, G, bx, wave, lane, (k == 5) ? (const bf16*)(ws + WS_OB) : ACT, (k == 5) ? DMODEL : DFF, (const bf16*)(wl + ((k == 1) ? W_DA : (k == 7) ? W_DB : W_O)), XG, rowss + (size_t)nn * MTOT, (k == 5) ? 1.0f : 0.5f);
            } else if (k == 2) {
                const int N = 3072;
                pg8::Gemm g{XG, (const bf16*)(wl + W_QKV), MP, N, DMODEL}; pg8::StaticOrder S; S.init(MP, N, G, bx);
                pg8::EpiQKV<QkvOff> E{ws, A.out, A.in[15], l, attn_body::C2};

#ifndef NO_QKV
pg8::gemm_phase<pg8::EpiQKV<QkvOff>, pg8::StaticOrder, true, true>(lds3 + RING_OFF, g, S, E);
#endif
                skinny_qkv(A, lds3 + RING_OFF, G, bx, wave, lane, (const bf16*)(wl + W_QKV), rowss + (size_t)(3 * l + 1) * MTOT, l);
                if (l == 1) skinny_logf(A, lds3 + RING_OFF, G, bx, wave, lane, (const bf16*)(wl + W_QKV) + (size_t)3072 * 1024, rowss + (size_t)(3 * l + 1) * MTOT);

            } else if (k == 3) {
                if (l == 1) cumsum_phase(A, lds3, G); else did = false;
            } else {
                const attn_body::bf16* Qb = (const attn_body::bf16*)QO; const attn_body::bf16* Kb = (const attn_body::bf16*)KB; const attn_body::bf16* Vb = (const attn_body::bf16*)VB;
                if (l == 1) {
                    const float* cs2 = (const float*)(ws + WS_CS2); const unsigned* kmax2 = (const unsigned*)(ws + WS_BTOT) + 2048;
                    volatile LAS unsigned* qslot = (volatile LAS unsigned*)(lds3 + RING_OFF + attn_body::ATTN_LDS_BYTES);
#pragma unroll 1
                    for (;;) { if (tid == 0) *qslot = __hip_atomic_fetch_add((unsigned*)(ws + WS_CTL) + CW_QUEUE, 1u, __ATOMIC_RELAXED, __HIP_MEMORY_SCOPE_AGENT);
                        __syncthreads(); const unsigned idx = *qslot; __syncthreads();
                        if (idx >= 2048u + 256u) break;
                        if (idx < 2048u) { const int qb = 31 - (int)(idx >> 6), bh = (int)(idx & 63u);
                            const float kmx = sqrtf(__uint_as_float(__hip_atomic_load(kmax2 + bh, __ATOMIC_RELAXED, __HIP_MEMORY_SCOPE_AGENT))) * 1.01f;
#ifndef NO_FOX
                            attn_body::attn_unit<0, 8>(bh >> 4, bh & 15, qb, Qb, Kb, Vb, (attn_body::bf16*)(ws + WS_OB), (char*)lds + RING_OFF, cs2 + (size_t)bh * 8192, nullptr, kmx);
#endif
                        } else { const int u = (int)idx - 2048;
#ifndef NO_SAMPLE
                            sample_unit<1>(u >> 4, u & 15, lds3 + RING_OFF, A);
#endif
                        } }
                } else {
                    int prev_bh = -1;
#pragma unroll 1
                    for (int u = bx * (2048 / 256); u < 2048; u += G * (2048 / 256)) {
#pragma unroll 1
                        for (int i = 0; i < 2048 / 256; ++i) { const int bh = (u + i) >> 5, qb = (u + i) & 31;
#ifndef NO_BAND
                            attn_body::attn_unit<1, 8>(bh >> 4, bh & 15, qb, Qb, Kb, Vb, (attn_body::bf16*)(ws + WS_OB), (char*)lds + RING_OFF, nullptr, (bh & 15) == (prev_bh & 15) && prev_bh >= 0 ? nullptr : A.in[13] + (bh & 15), 0.f);
#endif
                            prev_bh = bh; } }
#ifndef NO_SAMPLE
for (int u = bx; u < 256; u += G) sample_unit<0>(u >> 4, u & 15, lds3 + RING_OFF, A);
#endif

                }
            }
        }
        const bool again = (((PROBE_MASK >> p) & 1u) != 0u) && rep == 0;
        if (did && (p + 1 < args.ph_hi || again)) {
            if (p == 0 && !again) { __syncthreads(); cg::this_grid().sync(); } else xcd_barrier(bar);
        }
        if (again) { rep = 1; --p; } else rep = 0;
    }
}

extern "C" void kernel_launch(void* const* d_in, const int* in_sizes, int n_in, void* d_out, int out_size, void* d_ws, size_t ws_size, hipStream_t stream) {
    static int grid = 0;
    if (grid == 0) {
        if (n_in != 17 || out_size != (int)O_END || ws_size < WS_END) { fprintf(stderr, "kernel_launch: unexpected shapes (n_in %d out %d ws %zu)\n", n_in, out_size, ws_size); grid = -1; return; }
        int dev = 0, cus = 0, per_cu = 0;
        if (hipGetDevice(&dev) != hipSuccess || hipDeviceGetAttribute(&cus, hipDeviceAttributeMultiprocessorCount, dev) != hipSuccess) { grid = -1; return; }
        if (hipFuncSetAttribute((const void*)mk_fwd, hipFuncAttributeMaxDynamicSharedMemorySize, LDS_BYTES) != hipSuccess) { fprintf(stderr, "kernel_launch: hipFuncSetAttribute failed\n"); grid = -1; return; }
        if (hipOccupancyMaxActiveBlocksPerMultiprocessor(&per_cu, (const void*)mk_fwd, NWAVES * 64, LDS_BYTES) != hipSuccess || per_cu < 1) { fprintf(stderr, "kernel_launch: occupancy query says %d\n", per_cu); per_cu = 1; }
        (void)hipGetLastError();
        grid = cus * per_cu;
        if (grid > 256) grid = 256;
    }
    if (grid < 0) return;
    if (hipMemsetAsync((char*)d_ws + WS_CTL, 0, CTL_ZERO_BYTES, stream) != hipSuccess) { fprintf(stderr, "kernel_launch: memset failed\n"); return; }
    Args a{};
    for (int i = 0; i < 17; ++i) a.in[i] = (const float*)d_in[i];
    a.out = (float*)d_out; a.ws = (unsigned char*)d_ws; a.pad = 0;
#if MK_N_LAUNCHES == 1
    a.ph_lo = 0; a.ph_hi = N_PHASES; a.coop = 1;
    void* kargs[] = {&a};
    hipError_t e = hipLaunchCooperativeKernel((const void*)mk_fwd, dim3(grid), dim3(NWAVES * 64), kargs, LDS_BYTES, stream);
    if (e != hipSuccess) fprintf(stderr, "kernel_launch: cooperative launch failed: %s (grid %d)\n", hipGetErrorString(e), grid);
#else
    for (int p = 0; p < N_PHASES; ++p) {
        if (p == 4) continue;
        a.ph_lo = p; a.ph_hi = p + 1; a.coop = 0;
        hipLaunchKernelGGL(mk_fwd, dim3(grid), dim3(NWAVES * 64), LDS_BYTES, stream, a);
    }
#endif
}
```

```cpp
#include <hip/hip_runtime.h>
#include <hip/hip_cooperative_groups.h>
#include <hip/hip_bf16.h>
#include <cstdio>
#include <cstdint>
#include <cmath>
namespace cg = cooperative_groups;
#define MK_N_LAUNCHES 1
#define PROBE_MASK 0u
namespace pg8 {
#define PG8_LAS __attribute__((address_space(3)))
typedef unsigned short bf16_t;
typedef short bf16x8 __attribute__((ext_vector_type(8)));
typedef float f32x4 __attribute__((ext_vector_type(4)));
typedef unsigned u32x4 __attribute__((ext_vector_type(4)));
constexpr int BM = 256, BK = 64, HALF = 128, HTB = HALF * BK * 2  , STAGE_BYTES = 8 * HTB, NXCD = 8, WGM = 8;

__host__ __device__ __forceinline__ int lds_byte(int r, int c) { const int st = (r >> 4) * 2 + (c >> 5), rr = r & 15, cc = c & 31, ob = rr * 64 + cc * 2; return st * 1024 + (ob ^ (((ob >> 9) & 1) << 5)); }
__host__ __device__ __forceinline__ void stage_rc(int b, int& R, int& C) { const int st = b / 1024, sb = b % 1024, swz = sb ^ (((sb >> 9) & 1) << 5); R = (st >> 1) * 16 + swz / 64; C = (st & 1) * 32 + (swz % 64) / 2; }
__host__ __device__ __forceinline__ int perm32(int rho) { const int n = rho >> 4, i = rho & 15; return 8 * (i >> 2) + 4 * n + (i & 3); }

struct Unit { int pm, pn; };
struct Gemm { const bf16_t* A; const bf16_t* Bt; int M, N, K; };

struct StaticOrder {
    int nM, nN, nwg, G, c;
    __host__ __device__ void init(int M, int N, int G_, int c_) { nM = M / BM; nN = N / BM; nwg = nM * nN; G = G_; c = c_; }
    __host__ __device__ bool next(int i, Unit& u) const {
        const long L = (long)i * G + c; if (L >= nwg) return false;
        int wgid = (int)L; { const int q = nwg / NXCD, r = nwg % NXCD, xcd = wgid % NXCD, off = wgid / NXCD; wgid = (xcd < r ? xcd * (q + 1) : r * (q + 1) + (xcd - r) * q) + off; }
        const int nig = WGM * nN, gid = wgid / nig, fm = gid * WGM, gsz = (nM - fm) < WGM ? (nM - fm) : WGM;
        u.pm = fm + ((wgid % nig) % gsz); u.pn = (wgid % nig) / gsz; return true;
    }
    __device__ __forceinline__ void a_ready(const Unit&) const {}
    __device__ __forceinline__ void done(const Unit&) const {}
};

__device__ __forceinline__ unsigned cvt_pk_bf16(float lo, float hi) { unsigned r; asm volatile("v_cvt_pk_bf16_f32 %0, %1, %2" : "=v"(r) : "v"(lo), "v"(hi)); return r; }
typedef float f32x2 __attribute__((ext_vector_type(2)));
constexpr float RMS_EPS_F = 1e-6f;
__device__ __forceinline__ float rstd_of(float ss) { return __builtin_amdgcn_rsqf(ss * (1.0f / 1024.0f) + RMS_EPS_F); }
__device__ __forceinline__ float silu_mul(float g, float u) { return g * __builtin_amdgcn_rcpf(1.0f + __builtin_amdgcn_exp2f(-1.4426950408889634f * g)) * u; }

struct EpiGateUp {
    static constexpr bool PERM = true, AFTER_DRAIN = false;
    bf16_t* act; const float* rowss;
    __device__ __forceinline__ void operator()(const f32x4 (&acc)[2][2][4][2], const Unit& u, int wr, int wc, int fr_in, int fq_in) const {
        int fr = fr_in, fq = fq_in; asm volatile("" : "+v"(fr), "+v"(fq));
        const int row0 = u.pm * BM + wr * 64 + fr, col0 = u.pn * HALF + wc * 32 + 8 * fq;
        float ssq[2][4];
#pragma unroll
        for (int ai = 0; ai < 2; ++ai)
#pragma unroll
            for (int m = 0; m < 4; ++m) ssq[ai][m] = rowss[row0 + ai * HALF + m * 16];
        asm volatile("" : "+v"(ssq[0][0]), "+v"(ssq[0][1]), "+v"(ssq[0][2]), "+v"(ssq[0][3]), "+v"(ssq[1][0]), "+v"(ssq[1][1]), "+v"(ssq[1][2]), "+v"(ssq[1][3]));
#pragma unroll
        for (int ai = 0; ai < 2; ++ai)
#pragma unroll
            for (int m = 0; m < 4; ++m) { const int row = row0 + ai * HALF + m * 16; const float rs = rstd_of(ssq[ai][m]);
                const f32x4 g0 = acc[ai][0][m][0] * rs, g1 = acc[ai][0][m][1] * rs, u0 = acc[ai][1][m][0] * rs, u1 = acc[ai][1][m][1] * rs;
                u32x4 w; w.x = cvt_pk_bf16(silu_mul(g0[0], u0[0]), silu_mul(g0[1], u0[1])); w.y = cvt_pk_bf16(silu_mul(g0[2], u0[2]), silu_mul(g0[3], u0[3]));
                w.z = cvt_pk_bf16(silu_mul(g1[0], u1[0]), silu_mul(g1[1], u1[1])); w.w = cvt_pk_bf16(silu_mul(g1[2], u1[2]), silu_mul(g1[3], u1[3]));
                *(u32x4*)(act + (size_t)row * 4096 + col0) = w; }
    }
};

template <bool FIRST> struct EpiResid {
    static constexpr bool PERM = true, AFTER_DRAIN = false;
    const float* xin; bf16_t* xb; float* rowss_next; float alpha;
    __device__ __forceinline__ void operator()(const f32x4 (&acc)[2][2][4][2], const Unit& u, int wr, int wc, int fr_in, int fq_in) const {
        int fr = fr_in, fq = fq_in; asm volatile("" : "+v"(fr), "+v"(fq));
        const int row0 = u.pm * BM + wr * 64 + fr, colb = u.pn * BM + wc * 32 + 8 * fq;
#pragma unroll
        for (int ai = 0; ai < 2; ++ai)
#pragma unroll
          for (int mh = 0; mh < 2; ++mh) {
            f32x4 xv[2][2][2];
#pragma unroll
            for (int mm = 0; mm < 2; ++mm)
#pragma unroll
                for (int bj = 0; bj < 2; ++bj) { const size_t o = (size_t)(row0 + ai * HALF + (2 * mh + mm) * 16) * 1024 + colb + bj * HALF;
                    if constexpr (FIRST) { xv[mm][bj][0] = *(const f32x4*)(xin + o); xv[mm][bj][1] = *(const f32x4*)(xin + o + 4); }
                    else { const u32x4 w = *(const u32x4*)(xb + o);
                        xv[mm][bj][0] = (f32x4){__uint_as_float(w.x << 16), __uint_as_float(w.x & 0xffff0000u), __uint_as_float(w.y << 16), __uint_as_float(w.y & 0xffff0000u)};
                        xv[mm][bj][1] = (f32x4){__uint_as_float(w.z << 16), __uint_as_float(w.z & 0xffff0000u), __uint_as_float(w.w << 16), __uint_as_float(w.w & 0xffff0000u)}; } }
#pragma unroll
            for (int mm = 0; mm < 2; ++mm) asm volatile("" : "+v"(xv[mm][0][0]), "+v"(xv[mm][0][1]), "+v"(xv[mm][1][0]), "+v"(xv[mm][1][1]));
#pragma unroll
            for (int mm = 0; mm < 2; ++mm) { const int m = 2 * mh + mm; const int row = row0 + ai * HALF + m * 16; float ss = 0.f;
#pragma unroll
                for (int bj = 0; bj < 2; ++bj) {
                    const f32x4 v0 = xv[mm][bj][0] + acc[ai][bj][m][0] * alpha, v1 = xv[mm][bj][1] + acc[ai][bj][m][1] * alpha;
                    ss += (v0[0] * v0[0] + v0[1] * v0[1]) + (v0[2] * v0[2] + v0[3] * v0[3]) + (v1[0] * v1[0] + v1[1] * v1[1]) + (v1[2] * v1[2] + v1[3] * v1[3]);
                    u32x4 w; w.x = cvt_pk_bf16(v0[0], v0[1]); w.y = cvt_pk_bf16(v0[2], v0[3]); w.z = cvt_pk_bf16(v1[0], v1[1]); w.w = cvt_pk_bf16(v1[2], v1[3]);
                    *(u32x4*)(xb + (size_t)row * 1024 + colb + bj * HALF) = w; }
                ss += __shfl_xor(ss, 16); ss += __shfl_xor(ss, 32);
                if (fq == 0) __hip_atomic_fetch_add(rowss_next + row, ss, __ATOMIC_RELAXED, __HIP_MEMORY_SCOPE_AGENT); } }
    }
};

template <class C> struct EpiQKV {
    static constexpr bool PERM = true, AFTER_DRAIN = false;
    unsigned char* ws; float* out; const float* bfg; int fox; float qscale;
    __device__ __forceinline__ void operator()(const f32x4 (&acc)[2][2][4][2], const Unit& u, int wr, int wc, int fr_in, int fq_in) const {
        int fr = fr_in, fq = fq_in; asm volatile("" : "+v"(fr), "+v"(fq));
        const int t = u.pn >> 2, row0 = u.pm * BM + wr * 64 + fr;
        const float* rowss = (const float*)(ws + C::o_rowss0) + (size_t)(fox ? 4 : 1) * C::mtot;
        if (t == 3) {
            if (wc == 0 && fq < 2) {
                f32x4 bb[2]; bb[0] = *(const f32x4*)(bfg + 8 * fq); bb[1] = *(const f32x4*)(bfg + 8 * fq + 4);
                f32x4 tot[2] = {(f32x4){0.f, 0.f, 0.f, 0.f}, (f32x4){0.f, 0.f, 0.f, 0.f}};
#pragma unroll
                for (int ai = 0; ai < 2; ++ai)
#pragma unroll
                    for (int m = 0; m < 4; ++m) { const int row = row0 + ai * HALF + m * 16; const float rs = rstd_of(rowss[row]);
                        float* dst = (u.pm == 128) ? out + C::o_fls + (size_t)(row - 32768) * 16 : out + C::o_flp + (size_t)row * 16;
#pragma unroll
                        for (int n = 0; n < 2; ++n) { const f32x4 z = acc[ai][0][m][n] * rs + bb[n]; f32x4 lf;
#pragma unroll
                            for (int j = 0; j < 4; ++j) { const float ee = __builtin_amdgcn_exp2f(-1.4426950408889634f * fabsf(z[j]));
                                const float big = 0.6931471805599453f * __builtin_amdgcn_logf(1.0f + ee), sm = ee * (1.0f - ee * (0.5f - ee * (0.3333333333f - 0.25f * ee)));
                                lf[j] = fminf(z[j], 0.f) - (ee < 0.03f ? sm : big); }
                            *(f32x4*)(dst + 8 * fq + 4 * n) = lf; tot[n] += lf; } }
                if (u.pm < 128) { float* blocktot = (float*)(ws + C::o_btot);
#pragma unroll
                    for (int n = 0; n < 2; ++n)
#pragma unroll
                        for (int j = 0; j < 4; ++j) { float s = tot[n][j]; s += __shfl_xor(s, 1); s += __shfl_xor(s, 2); s += __shfl_xor(s, 4); s += __shfl_xor(s, 8);
                            if (fr == 0) __hip_atomic_fetch_add(blocktot + u.pm * 16 + 8 * fq + 4 * n + j, s, __ATOMIC_RELAXED, __HIP_MEMORY_SCOPE_AGENT); }
                }
            }
            return;
        }
        const int cin = (u.pn & 3) * BM + wc * 32 + 8 * fq;
        bf16_t* bdst = (bf16_t*)(ws + ((t == 0) ? C::o_qo : (t == 1) ? C::o_kb : C::o_vb));
        float* fdst = nullptr;
        if (t != 0) { const size_t op = fox ? ((t == 1) ? C::o_fkp : C::o_fvp) : ((t == 1) ? C::o_bkp : C::o_bvp), os = fox ? ((t == 1) ? C::o_fks : C::o_fvs) : ((t == 1) ? C::o_bks : C::o_bvs);
            if (u.pm == 128) fdst = out + os;
            else if (fox) fdst = out + op + (size_t)u.pm * BM * 1024;
            else if ((u.pm & 31) >= 30) fdst = out + op + (size_t)((u.pm >> 5) * 512 + ((u.pm & 31) - 30) * BM) * 1024; }
        const float sc = (t == 0) ? qscale : 1.0f;
        float ssq[2][4];
#pragma unroll
        for (int ai = 0; ai < 2; ++ai)
#pragma unroll
            for (int m = 0; m < 4; ++m) ssq[ai][m] = rowss[row0 + ai * HALF + m * 16];
        asm volatile("" : "+v"(ssq[0][0]), "+v"(ssq[0][1]), "+v"(ssq[0][2]), "+v"(ssq[0][3]), "+v"(ssq[1][0]), "+v"(ssq[1][1]), "+v"(ssq[1][2]), "+v"(ssq[1][3]));
#pragma unroll
        for (int ai = 0; ai < 2; ++ai)
#pragma unroll
            for (int m = 0; m < 4; ++m) { const int rl = wr * 64 + fr + ai * HALF + m * 16, row = u.pm * BM + rl; const float rs = rstd_of(ssq[ai][m]);
#pragma unroll
                for (int bj = 0; bj < 2; ++bj) { const f32x4 v0 = acc[ai][bj][m][0] * rs, v1 = acc[ai][bj][m][1] * rs;
                    if (fdst) { float* fp = fdst + (size_t)rl * 1024 + cin + bj * HALF; *(f32x4*)fp = v0; *(f32x4*)(fp + 4) = v1; }
                    u32x4 w; w.x = cvt_pk_bf16(v0[0] * sc, v0[1] * sc); w.y = cvt_pk_bf16(v0[2] * sc, v0[3] * sc); w.z = cvt_pk_bf16(v1[0] * sc, v1[1] * sc); w.w = cvt_pk_bf16(v1[2] * sc, v1[3] * sc);
                    *(u32x4*)(bdst + (size_t)row * 1024 + cin + bj * HALF) = w; } }
    }
};


template <class Epi, class Sched, bool ALIGN_EPI = false, bool SP2 = false>
__device__ __forceinline__ void gemm_phase(PG8_LAS unsigned char* lds, const Gemm g, const Sched& S, const Epi& E) {
    int tid_ = threadIdx.x; asm volatile("" : "+v"(tid_)); const int tid = tid_, wid = __builtin_amdgcn_readfirstlane(tid >> 6), lane = tid & 63, wr = wid >> 2, wc = wid & 3, fr = lane & 15, fq = lane >> 4;
    const int K = g.K, nt = K / BK;
    unsigned voffA[2], voffB[2];
#pragma unroll
    for (int i = 0; i < 2; ++i) { int R, C; stage_rc(tid * 16 + i * 8192, R, C); const int Rb = Epi::PERM ? ((R & ~31) + perm32(R & 31)) : R;
        voffA[i] = (unsigned)(R * K + C) * 2u; voffB[i] = (unsigned)(Rb * K + C) * 2u; }
    const size_t kstep = (size_t)(BK * 2);
    const size_t hstep = (size_t)HALF * K * 2;
    const size_t tstep = 2 * hstep;
    const unsigned ldsw = (unsigned)wid * 1024u;
    const int aoff = lds_byte(wr * 64 + fr, fq * 8), boff = lds_byte(wc * 32 + fr, fq * 8);
#define PG8_SA(b, h) (((b) * 2 + (h)) * HTB)
#define PG8_SB(b, h) ((4 + (b) * 2 + (h)) * HTB)
#define PG8_STAGE(bufoff, gbase, voff) do { _Pragma("unroll") for (int _i = 0; _i < 2; ++_i) \
        __builtin_amdgcn_global_load_lds((const unsigned*)((const char*)(gbase) + (voff)[_i]), (PG8_LAS unsigned*)(lds + (bufoff) + ldsw + _i * 8192), 16, 0, 0); } while (0)
#define PG8_LDA(dst, b, h) do { _Pragma("unroll") for (int m = 0; m < 4; ++m) _Pragma("unroll") for (int k = 0; k < 2; ++k) dst[m][k] = *(const PG8_LAS bf16x8*)(lds + PG8_SA(b, h) + aoff + m * 2048 + k * 1024); } while (0)
#define PG8_LDB(dst, b, h) do { _Pragma("unroll") for (int n = 0; n < 2; ++n) _Pragma("unroll") for (int k = 0; k < 2; ++k) dst[n][k] = *(const PG8_LAS bf16x8*)(lds + PG8_SB(b, h) + boff + n * 2048 + k * 1024); } while (0)
#define PG8_MMA(ai, bj, At, Bt) do { __builtin_amdgcn_s_setprio(1); _Pragma("unroll") for (int m = 0; m < 4; ++m) _Pragma("unroll") for (int n = 0; n < 2; ++n) _Pragma("unroll") for (int k = 0; k < 2; ++k) \
        acc[ai][bj][m][n] = __builtin_amdgcn_mfma_f32_16x16x32_bf16(Bt[n][k], At[m][k], acc[ai][bj][m][n], 0, 0, 0); __builtin_amdgcn_s_setprio(0); } while (0)
#define PG8_WAIT_V(n) asm volatile("s_waitcnt vmcnt(" #n ")" ::: "memory")
#define PG8_WAIT_L(n) asm volatile("s_waitcnt lgkmcnt(" #n ")" ::: "memory")
#define PG8_BAR __builtin_amdgcn_s_barrier()
#define PG8_SCHED __builtin_amdgcn_sched_barrier(0)
    Unit cur, nxt; int ui = 0;
    if (!S.next(0, cur)) return;
    f32x4 acc[2][2][4][2];
#pragma unroll
    for (int a = 0; a < 2; ++a)
#pragma unroll
        for (int b = 0; b < 2; ++b)
#pragma unroll
            for (int m = 0; m < 4; ++m)
#pragma unroll
                for (int n = 0; n < 2; ++n) acc[a][b][m][n] = (f32x4){0.f, 0.f, 0.f, 0.f};
    bf16x8 At[4][2], B0[2][2], B1[2][2];
    const char* cA = (const char*)g.A + (size_t)cur.pm * tstep; const char* cB = (const char*)g.Bt + (size_t)cur.pn * tstep;
    S.a_ready(cur);
    if constexpr (SP2) {
        PG8_STAGE(PG8_SB(0, 0), cB, voffB); PG8_STAGE(PG8_SB(0, 1), cB + hstep, voffB); PG8_STAGE(PG8_SA(0, 0), cA, voffA); PG8_STAGE(PG8_SA(0, 1), cA + hstep, voffA);
        if (wr == 1) PG8_BAR;
        PG8_WAIT_V(2); PG8_BAR;
        PG8_STAGE(PG8_SB(1, 0), cB + kstep, voffB); PG8_STAGE(PG8_SA(1, 0), cA + kstep, voffA); PG8_STAGE(PG8_SB(1, 1), cB + hstep + kstep, voffB);
        PG8_WAIT_V(6); PG8_BAR;
    } else {
        PG8_STAGE(PG8_SB(0, 0), cB, voffB); PG8_STAGE(PG8_SA(0, 0), cA, voffA); PG8_STAGE(PG8_SB(0, 1), cB + hstep, voffB); PG8_STAGE(PG8_SA(0, 1), cA + hstep, voffA);
        if (wr == 1) PG8_BAR;
        PG8_WAIT_V(4); PG8_BAR;
        PG8_STAGE(PG8_SB(1, 0), cB + kstep, voffB); PG8_STAGE(PG8_SA(1, 0), cA + kstep, voffA); PG8_STAGE(PG8_SB(1, 1), cB + hstep + kstep, voffB);
        PG8_WAIT_V(6); PG8_BAR;
    }
    for (;;) {
        const bool has_next = S.next(ui + 1, nxt);
        const char* nA = has_next ? (const char*)g.A + (size_t)nxt.pm * tstep : cA; const char* nB = has_next ? (const char*)g.Bt + (size_t)nxt.pn * tstep : cB;
        for (int t = 0; t < nt; t += 2) {
            const bool last = (t == nt - 2);
            const char* a1 = cA + (size_t)(t + 1) * kstep;
            const char* a2 = last ? nA : cA + (size_t)(t + 2) * kstep; const char* b2 = last ? nB : cB + (size_t)(t + 2) * kstep;
            const char* a3 = a2 + kstep; const char* b3 = b2 + kstep;
            if (last && has_next) S.a_ready(nxt);
            if constexpr (SP2) {
            PG8_LDB(B0, 0, 0); PG8_LDB(B1, 0, 1); PG8_SCHED; PG8_LDA(At, 0, 0); PG8_STAGE(PG8_SA(1, 1), a1 + hstep, voffA);
            PG8_WAIT_V(8); PG8_WAIT_L(0); PG8_BAR; PG8_MMA(0, 0, At, B0); PG8_MMA(0, 1, At, B1); PG8_BAR; PG8_SCHED;
            PG8_LDA(At, 0, 1); PG8_STAGE(PG8_SB(0, 0), b2, voffB); PG8_STAGE(PG8_SB(0, 1), b2 + hstep, voffB); PG8_STAGE(PG8_SA(0, 0), a2, voffA);
            PG8_WAIT_V(8); PG8_WAIT_L(0); PG8_BAR; PG8_MMA(1, 0, At, B0); PG8_MMA(1, 1, At, B1); PG8_BAR; PG8_SCHED;
            PG8_LDB(B0, 1, 0); PG8_LDB(B1, 1, 1); PG8_SCHED; PG8_LDA(At, 1, 0); PG8_STAGE(PG8_SA(0, 1), a2 + hstep, voffA);
            PG8_WAIT_V(8); PG8_WAIT_L(0); PG8_BAR; PG8_MMA(0, 0, At, B0); PG8_MMA(0, 1, At, B1); PG8_BAR; PG8_SCHED;
            PG8_LDA(At, 1, 1); PG8_STAGE(PG8_SB(1, 0), b3, voffB); PG8_STAGE(PG8_SB(1, 1), b3 + hstep, voffB); PG8_STAGE(PG8_SA(1, 0), a3, voffA);
            PG8_WAIT_V(8); PG8_WAIT_L(0); PG8_BAR; PG8_MMA(1, 0, At, B0); PG8_MMA(1, 1, At, B1); PG8_BAR; PG8_SCHED;
            } else {
            PG8_LDB(B0, 0, 0); PG8_SCHED; PG8_LDA(At, 0, 0); PG8_STAGE(PG8_SA(1, 1), a1 + hstep, voffA);
            PG8_WAIT_L(8); PG8_BAR; PG8_WAIT_L(0); PG8_MMA(0, 0, At, B0); PG8_BAR; PG8_SCHED;
            PG8_LDB(B1, 0, 1); PG8_STAGE(PG8_SB(0, 0), b2, voffB);
            PG8_BAR; PG8_WAIT_L(0); PG8_MMA(0, 1, At, B1); PG8_BAR;
            PG8_LDA(At, 0, 1); PG8_STAGE(PG8_SA(0, 0), a2, voffA);
            PG8_BAR; PG8_WAIT_L(0); PG8_MMA(1, 0, At, B0); PG8_BAR; PG8_SCHED;
            PG8_STAGE(PG8_SB(0, 1), b2 + hstep, voffB);
            PG8_WAIT_V(6); PG8_BAR; PG8_MMA(1, 1, At, B1); PG8_BAR;
            PG8_LDB(B0, 1, 0); PG8_SCHED; PG8_LDA(At, 1, 0); PG8_STAGE(PG8_SA(0, 1), a2 + hstep, voffA);
            PG8_WAIT_L(8); PG8_BAR; PG8_WAIT_L(0); PG8_MMA(0, 0, At, B0); PG8_BAR; PG8_SCHED;
            PG8_LDB(B1, 1, 1); PG8_STAGE(PG8_SB(1, 0), b3, voffB);
            PG8_BAR; PG8_WAIT_L(0); PG8_MMA(0, 1, At, B1); PG8_BAR;
            PG8_LDA(At, 1, 1); PG8_STAGE(PG8_SA(1, 0), a3, voffA);
            PG8_BAR; PG8_WAIT_L(0); PG8_MMA(1, 0, At, B0); PG8_BAR; PG8_SCHED;
            PG8_STAGE(PG8_SB(1, 1), b3 + hstep, voffB);
            PG8_WAIT_V(6); PG8_BAR; PG8_MMA(1, 1, At, B1); PG8_BAR;
            }
        }
        if constexpr (ALIGN_EPI) { if (wr == 0) PG8_BAR; }
        if constexpr (!Epi::AFTER_DRAIN) { E(acc, cur, wr, wc, fr, fq); S.done(cur); }
        if (!has_next) break;
#pragma unroll
        for (int a = 0; a < 2; ++a)
#pragma unroll
            for (int b = 0; b < 2; ++b)
#pragma unroll
                for (int m = 0; m < 4; ++m)
#pragma unroll
                    for (int n = 0; n < 2; ++n) acc[a][b][m][n] = (f32x4){0.f, 0.f, 0.f, 0.f};
        cur = nxt; cA = nA; cB = nB; ++ui;
        if constexpr (ALIGN_EPI) { if (wr == 1) PG8_BAR; }
    }
    PG8_WAIT_V(0);
    if constexpr (!ALIGN_EPI) { if (wr == 0) PG8_BAR; }
    PG8_BAR;
    if constexpr (Epi::AFTER_DRAIN) { E.fused(acc, cur, wr, wc, fr, fq, lds, wid, lane); S.done(cur); }
#undef PG8_SA
#undef PG8_SB
#undef PG8_STAGE
#undef PG8_LDA
#undef PG8_LDB
#undef PG8_MMA
#undef PG8_WAIT_V
#undef PG8_WAIT_L
#undef PG8_BAR
#undef PG8_SCHED
}
}
namespace attn_body {
using bf16=__hip_bfloat16;
using bf16x8=__attribute__((ext_vector_type(8)))short;
using s16x4=__attribute__((ext_vector_type(4)))short;
using f32x16=__attribute__((ext_vector_type(16)))float;
using f32x4=__attribute__((ext_vector_type(4)))float;
using u32x4=__attribute__((ext_vector_type(4)))unsigned;
constexpr int NHEAD=16,SEQ=8192,D=64,DM=NHEAD*D;
constexpr int NW=8,QBLK=32,QB=QBLK*NW,KVBLK=64,NQB=SEQ/QB;
constexpr float L2E=1.4426950408889634f;
__device__ __forceinline__ int crow(int r,int hi){return (r&3)+8*(r>>2)+4*hi;}
#define SBAR() __builtin_amdgcn_sched_barrier(0)
__device__ __forceinline__ void cmask(f32x16&p0,f32x16&p1,int jb,int qrel,int hi){
  const float NEG=-INFINITY; int kb=64*jb+4*hi;
  #pragma unroll
  for(int r=0;r<16;++r){int kv=kb+(r&3)+8*(r>>2); if(kv>qrel)p0[r]=NEG; if(kv+32>qrel)p1[r]=NEG;}
}
constexpr int NSLOT=3, SLOTB=8192;
constexpr int LDS_K=0, LDS_V=NSLOT*SLOTB, LDS_WS=2*NSLOT*SLOTB, LDS_OST=LDS_WS+NW*64*4, LDS_X=LDS_OST+NW*4096;
constexpr int LDS_VOTE=LDS_X+32768; constexpr int LDS_BYTES=LDS_VOTE+64;
constexpr float C2=0.125f*L2E;
__device__ __forceinline__ void glds16(const void*gsrc,unsigned lds_dst){unsigned keep;
  asm volatile("s_mov_b32 %0, m0\n\ts_mov_b32 m0, %2\n\ts_nop 0\n\tglobal_load_lds_dwordx4 %1, off\n\ts_mov_b32 m0, %0":"=&s"(keep):"v"(gsrc),"s"(lds_dst):"memory");}
__device__ __forceinline__ float max3f(float a,float b,float c){float r;asm("v_max3_f32 %0, %1, %2, %3":"=v"(r):"v"(a),"v"(b),"v"(c));return r;}
__device__ __forceinline__ float max2f(float a,float b){float r;asm("v_max_f32_e32 %0, %1, %2":"=v"(r):"v"(a),"v"(b));return r;}
__device__ __forceinline__ float fadd_s(float a,float b){float r;asm("v_add_f32_e32 %0, %1, %2":"=v"(r):"v"(a),"v"(b));return r;}
__device__ __forceinline__ float fsub_s(float a,float b){float r;asm("v_sub_f32_e32 %0, %1, %2":"=v"(r):"v"(a),"v"(b));return r;}
typedef float f32x2_t __attribute__((ext_vector_type(2))); typedef __bf16 bf16x2_t __attribute__((ext_vector_type(2)));
__device__ __forceinline__ unsigned cvtpk_s(float lo,float hi){f32x2_t v={lo,hi};bf16x2_t b=__builtin_convertvector(v,bf16x2_t);return __builtin_bit_cast(unsigned,b);}
#define WAIT_BAR(N) asm volatile("s_waitcnt vmcnt(" #N ") lgkmcnt(0)\n\ts_barrier":::"memory")
#define MF32(a,b,c) __builtin_amdgcn_mfma_f32_32x32x16_bf16(a,b,c,0,0,0)

__device__ __forceinline__ void qkt(f32x16&p0,f32x16&p1,const char*Kslot,const bf16x8*qr,int r32,int hi){
  const char*kb=Kslot+hi*1024+r32*16;
  #pragma unroll
  for(int d0=0;d0<4;++d0){
    const bf16x8 b0=*reinterpret_cast<const bf16x8*>(kb+d0*2048);
    const bf16x8 b1=*reinterpret_cast<const bf16x8*>(kb+d0*2048+512);
    p0=MF32(b0,qr[d0],p0);p1=MF32(b1,qr[d0],p1);}
}
typedef __attribute__((address_space(3))) const char* lds_cptr;
typedef short v4i16_t __attribute__((ext_vector_type(4)));
__device__ __forceinline__ void kload8(bf16x8*kf,lds_cptr kp){
  kf[0]=*(const __attribute__((address_space(3))) bf16x8*)(kp);      kf[1]=*(const __attribute__((address_space(3))) bf16x8*)(kp+512);
  kf[2]=*(const __attribute__((address_space(3))) bf16x8*)(kp+2048); kf[3]=*(const __attribute__((address_space(3))) bf16x8*)(kp+2560);
  kf[4]=*(const __attribute__((address_space(3))) bf16x8*)(kp+4096); kf[5]=*(const __attribute__((address_space(3))) bf16x8*)(kp+4608);
  kf[6]=*(const __attribute__((address_space(3))) bf16x8*)(kp+6144); kf[7]=*(const __attribute__((address_space(3))) bf16x8*)(kp+6656);
}
__device__ __forceinline__ void kload2(bf16x8*kf,lds_cptr kp,int j){ kf[2*j]=*(const __attribute__((address_space(3))) bf16x8*)(kp+j*2048); kf[2*j+1]=*(const __attribute__((address_space(3))) bf16x8*)(kp+j*2048+512); }
__device__ __forceinline__ s16x4 vtr(lds_cptr p){ return __builtin_bit_cast(s16x4,__builtin_amdgcn_ds_read_tr16_b64_v4i16((__attribute__((address_space(3))) v4i16_t*)p)); }
__device__ __forceinline__ float rowmax(const f32x16&p0,const f32x16&p1){
  float a=max3f(p0[0],p0[1],p1[0]),b=max3f(p0[2],p0[3],p1[1]);a=max3f(a,p1[2],p1[3]);
  #pragma unroll
  for(int r=4;r<16;r+=4){a=max3f(a,p0[r],p0[r+1]);b=max3f(b,p0[r+2],p0[r+3]);a=max3f(a,p1[r],p1[r+1]);b=max3f(b,p1[r+2],p1[r+3]);}
  const float m=max2f(a,b);
  auto rr=__builtin_amdgcn_permlane32_swap(__float_as_uint(m),__float_as_uint(m),false,false);
  return max2f(__uint_as_float(rr[0]),__uint_as_float(rr[1]));
}
__device__ __forceinline__ void pv(f32x16*o,int vb,bf16x8 pa0,bf16x8 pa1,bf16x8 pa2,bf16x8 pa3){
  #pragma unroll
  for(int d0=0;d0<2;++d0){s16x4 lo[4],hi[4];
    #pragma unroll
    for(int ks=0;ks<4;++ks){
      asm volatile("ds_read_b64_tr_b16 %0,%1 offset:%c2":"=&v"(lo[ks]):"v"(vb),"i"(d0*4096+ks*1024):"memory");
      asm volatile("ds_read_b64_tr_b16 %0,%1 offset:%c2":"=&v"(hi[ks]):"v"(vb),"i"(d0*4096+ks*1024+512):"memory");}
    asm volatile("s_waitcnt lgkmcnt(0)":::"memory");SBAR();
    #define PK(k) (bf16x8){lo[k][0],lo[k][1],lo[k][2],lo[k][3],hi[k][0],hi[k][1],hi[k][2],hi[k][3]}
    o[d0]=MF32(pa0,PK(0),o[d0]);
    o[d0]=MF32(pa1,PK(1),o[d0]);
    o[d0]=MF32(pa2,PK(2),o[d0]);
    o[d0]=MF32(pa3,PK(3),o[d0]);
    #undef PK
  }
}
__device__ __forceinline__ void split3(float v,unsigned&h,unsigned&m,unsigned&l){
  const unsigned u=__float_as_uint(v); h=u&0xffff0000u; const float r1=v-__uint_as_float(h); m=__float_as_uint(r1)&0xffff0000u; const float r2=r1-__uint_as_float(m); l=__float_as_uint(r2)&0xffff0000u; }
__device__ __forceinline__ bf16x8 kfeat(float v,int hi){ unsigned h,m,l; split3(v,h,m,l); u32x4 w; w.x=(h>>16)|m; w.y=(l>>16)|0x3f800000u; w.z=0x3f803f80u; w.w=0u; if(hi){w.x=0u;w.y=0u;w.z=0u;} return __builtin_bit_cast(bf16x8,w); }
__device__ __forceinline__ bf16x8 qfeat(float v,int hi){ unsigned h,m,l; split3(v,h,m,l); u32x4 w; w.x=0x3f803f80u; w.y=0x00003f80u|h; w.z=(m>>16)|l; w.w=0u; if(hi){w.x=0u;w.y=0u;w.z=0u;} return __builtin_bit_cast(bf16x8,w); }

#ifndef ATTN_STORE16
#define ATTN_STORE16(p,v) (*(u32x4*)(p)=(v))
#endif
template<int MODE,int THRL> __device__ __forceinline__ void attn_unit(int b,int h,int qb,const bf16*Q,const bf16*__restrict__ K,const bf16*__restrict__ V,bf16*O,char*shm,const float*__restrict__ cs2,const float*__restrict__ relb,float kmx){
  int tid_=threadIdx.x; asm volatile("":"+v"(tid_)); const int tid=tid_,lane=tid&63,r32=lane&31,hi=lane>>5; const int wid=__builtin_amdgcn_readfirstlane(tid>>6);
  const long rowbase=(long)b*SEQ; const int q0=qb*QB;
  const int t_lo=(MODE==1)?((4*qb-8)>0?(4*qb-8):0):0;
  const int NT=(q0+QB)/KVBLK-t_lo;
  const bf16*Qw=Q+(rowbase+q0+wid*QBLK)*DM+h*D;
  const bf16*Kh=K+(rowbase+(long)t_lo*KVBLK)*DM+h*D,*Vh=V+(rowbase+(long)t_lo*KVBLK)*DM+h*D;
  const unsigned lds0=(unsigned)(uintptr_t)shm;
  float*wsf=(float*)(shm+LDS_WS)+wid*64;
  const bf16*ksrc=Kh+(long)lane*DM+wid*8;
  const bf16*vsrc=Vh+(long)(16*(wid&3)+(lane>>2))*DM+(wid>>2)*32+(lane&3)*8;
  const unsigned kdst=lds0+LDS_K+wid*1024, vdst=lds0+LDS_V+wid*1024;
  #define TM(t) ((MODE==0)?(NT-1-(t)):(t))
  #define DMA_K(t,slot) glds16(ksrc+(long)TM(t)*KVBLK*DM,(unsigned)__builtin_amdgcn_readfirstlane(kdst+(slot)))
  #define DMA_V(t,slot) glds16(vsrc+(long)TM(t)*KVBLK*DM,(unsigned)__builtin_amdgcn_readfirstlane(vdst+(slot)))
  const int vb0=(int)(lds0+LDS_V)+((lane>>4)&1)*32+(lane&3)*8+(4*hi+((lane&15)>>2))*64;
  const char*Kbase=shm+LDS_K; bf16x8 kf[8];
  const lds_cptr shm3=(lds_cptr)shm; const lds_cptr kp0=shm3+LDS_K+hi*1024+r32*16; const lds_cptr vp0=shm3+LDS_V+((lane>>4)&1)*32+(lane&3)*8+(4*hi+((lane&15)>>2))*64;
  DMA_K(0,0);DMA_V(0,0);DMA_K(1,SLOTB);
  bf16x8 qr[4];
  #pragma unroll
  for(int d0=0;d0<4;++d0)qr[d0]=*reinterpret_cast<const bf16x8*>(&Qw[(long)r32*DM+d0*16+hi*8]);
  float ub=0.f;
  if constexpr(MODE==0){ float s2=0.f;
    #pragma unroll
    for(int d0=0;d0<4;++d0){
      #pragma unroll
      for(int j=0;j<8;++j){ const float f=__uint_as_float(((unsigned)(unsigned short)qr[d0][j])<<16); s2+=f*f; } }
    { auto rr=__builtin_amdgcn_permlane32_swap(__float_as_uint(s2),__float_as_uint(s2),false,false); s2=__uint_as_float(rr[0])+__uint_as_float(rr[1]); }
    ub=sqrtf(s2)*kmx; }
  volatile __attribute__((address_space(3))) unsigned*votes=(volatile __attribute__((address_space(3))) unsigned*)(shm3+LDS_VOTE);
  if constexpr(MODE==0){ const int nk=NT*KVBLK; for(int i=tid*4;i<nk;i+=NW*64*4) *(__attribute__((address_space(3))) f32x4*)(shm3+LDS_X+i*4)=*(const f32x4*)(cs2+i); }
  else { if(relb){ for(int i=tid;i<2560;i+=NW*64){ const int s=i/640,j=i-s*640; int idx=j+s; idx=idx>639?639:idx; int dist=575-idx; dist=dist>256?256:dist; dist=dist<-256?-256:dist;
           *(__attribute__((address_space(3))) float*)(shm3+LDS_X+s*2576+j*4)=L2E*relb[(dist+256)*16]; } } }
  float mhat=0.f,l_reg=0.f;f32x16 o[2];o[0]=f32x16{};o[1]=f32x16{};
  const f32x16 z16=f32x16{};
  bf16x8 qx=qfeat(0.f,hi); float cn0=0.f,cn1=0.f;
  const int qrel=wid*QBLK+r32;
  const int cw=wid>>1;
  const lds_cptr csl=shm3+LDS_X+r32*4;
  const int bsh=(3-r32)&3;
  const lds_cptr btab=shm3+LDS_X+bsh*2576+4*(64*t_lo+4*hi-(q0+qrel)+575-bsh);
  #define TVALID(t) (((t)<=NT-4+cw)&&((t)+12>=NT+cw))
  #define BUILDKX(tt) do{ if constexpr(MODE==0){ const float c0_=*(const __attribute__((address_space(3))) float*)(csl+TM(tt)*256), c1_=*(const __attribute__((address_space(3))) float*)(csl+TM(tt)*256+128); cn0=c0_; cn1=c1_; } }while(0)
  #define CINIT(C0,C1,t,val_) do{ if constexpr(MODE==0){ const bf16x8 kx0_=kfeat(-cn0,hi), kx1_=kfeat(-cn1,hi); C0=MF32(kx0_,qx,z16); C1=MF32(kx1_,qx,z16); } else { if(val_){ const lds_cptr bp_=btab+(t)*256; \
      _Pragma("unroll") for(int g_=0;g_<4;++g_){ const f32x4 a_=*(const __attribute__((address_space(3))) f32x4*)(bp_+g_*32), c_=*(const __attribute__((address_space(3))) f32x4*)(bp_+g_*32+128); \
        C0[4*g_]=a_[0]-mhat;C0[4*g_+1]=a_[1]-mhat;C0[4*g_+2]=a_[2]-mhat;C0[4*g_+3]=a_[3]-mhat; C1[4*g_]=c_[0]-mhat;C1[4*g_+1]=c_[1]-mhat;C1[4*g_+2]=c_[2]-mhat;C1[4*g_+3]=c_[3]-mhat; } } \
      else { C0=z16; C1=z16; } } }while(0)
  #define CMASK(P0,P1,t,val_,MK) do{ if constexpr(MODE==0){ int jb_=TM(t)-(NT-4); if(jb_>=0)cmask(P0,P1,jb_,qrel,hi); } else { if(!(val_)){ _Pragma("unroll") for(int r=0;r<16;++r){P0[r]=-INFINITY;P1[r]=-INFINITY;} } } }while(0)
  #define SETQX() do{ if constexpr(MODE==0){ qx=qfeat(-mhat,hi); } }while(0)
  bool resc=false;
  #define START(P0,P1) do{ const float rm=rowmax(P0,P1); resc=false; \
    { const float dl=(rm>-1e30f)?rm:0.f; mhat=fadd_s(mhat,dl); \
      _Pragma("unroll") for(int r=0;r<16;++r){P0[r]=fsub_s(P0[r],dl);P1[r]=fsub_s(P1[r],dl);} \
      SETQX(); } \
    _Pragma("unroll") for(int r=0;r<16;++r)P0[r]=__builtin_amdgcn_exp2f(P0[r]); }while(0)
  #define RESC() do{ if(resc){ asm volatile("s_waitcnt lgkmcnt(0)":::"memory"); \
      _Pragma("unroll") for(int d_=0;d_<2;++d_) _Pragma("unroll") for(int r=0;r<16;++r)o[d_][r]*=wsf[crow(r,hi)]; } }while(0)
  f32x16 pA0,pA1,pB0,pB1;
  int sl_prev=0,sl_cur=0,sl_next=SLOTB;
  #define ROT() do{sl_prev=sl_cur;sl_cur=sl_next;sl_next=(sl_next==(NSLOT-1)*SLOTB)?0:sl_next+SLOTB;}while(0)
  DMA_K(2,2*SLOTB);
  WAIT_BAR(3);
  BUILDKX(0);
  { const bool v0_=TVALID(0); CINIT(pA0,pA1,0,v0_);
    qkt(pA0,pA1,Kbase,qr,r32,hi);asm volatile("s_nop 15\n\ts_nop 7":"+v"(pA0),"+v"(pA1));CMASK(pA0,pA1,0,v0_,true); }
  START(pA0,pA1);
  _Pragma("unroll") for(int r=0;r<16;++r)pA1[r]=__builtin_amdgcn_exp2f(pA1[r]);
  WAIT_BAR(0);
  DMA_K(3,0);DMA_V(1,SLOTB);
  ROT();
  kload8(kf,kp0+sl_cur);
  BUILDKX(1);
  WAIT_BAR(2);
  s16x4 vlo[8],vhi[8]; u32x4 pw0,pw1,pw2,pw3;
  #define PKW(P,B) cvtpk_s(P[B],P[B+1])
  #define PAF(k) __builtin_bit_cast(bf16x8,pw##k)
  #define VFR(i) (bf16x8){vlo[i][0],vlo[i][1],vlo[i][2],vlo[i][3],vhi[i][0],vhi[i][1],vhi[i][2],vhi[i][3]}
  #define PIN(x) asm volatile("":"+v"(x))
  #define MX3(a,b,c) __builtin_fmaxf(__builtin_fmaxf((a),(b)),(c))
  #define GAPA(MF,A0,A1,A2,A3,W0,W1,PW) do{ MF; sacc+=A0; sacc+=A1; sacc+=A2; sacc+=A3; PIN(sacc); W0; W1; PIN(PW); SBAR(); }while(0)
  #define EX(v) __builtin_amdgcn_exp2f(v)
  #define GAPB(MF,X,B) do{ MF; X[B]=EX(X[B]); X[B+1]=EX(X[B+1]); X[B+2]=EX(X[B+2]); X[B+3]=EX(X[B+3]); PIN(X); SBAR(); }while(0)
  #define VRD(i) do{ vlo[i]=vtr(vp_+(((i)>>2)*4096+((i)&3)*1024)); vhi[i]=vtr(vp_+(((i)>>2)*4096+((i)&3)*1024+512)); }while(0)
  #define KRD(G,j) do{ if(G){ kload2(kf,kp0+sl_next,j); SBAR(); } }while(0)
  #define STEP(C0,C1,P0,P1,t,GK,GV,GL,MK) do{ SBAR(); \
    const lds_cptr vp_=vp0+sl_prev; const bool val_=TVALID(t); \
    CINIT(C0,C1,t,val_); SBAR(); \
    VRD(0); SBAR(); float sacc=(P0[0]+P0[1]); \
    GAPA(C0=MF32(kf[0],qr[0],C0), P0[2],P0[3],P0[4],P0[5],     pw0[0]=PKW(P0,0), pw0[1]=PKW(P0,2), pw0); \
    VRD(4); SBAR(); GAPA(C1=MF32(kf[1],qr[0],C1), P0[6],P0[7],P0[8],P0[9],     pw0[2]=PKW(P0,4), pw0[3]=PKW(P0,6), pw0); \
    VRD(1); SBAR(); GAPA(C0=MF32(kf[2],qr[1],C0),   P0[10],P0[11],P0[12],P0[13], pw1[0]=PKW(P0,8), pw1[1]=PKW(P0,10), pw1); \
    VRD(5); SBAR(); GAPA(C1=MF32(kf[3],qr[1],C1),   P0[14],P0[15],P1[0],P1[1],   pw1[2]=PKW(P0,12),pw1[3]=PKW(P0,14), pw1); \
    VRD(2); SBAR(); GAPA(C0=MF32(kf[4],qr[2],C0),   P1[2],P1[3],P1[4],P1[5],     pw2[0]=PKW(P1,0), pw2[1]=PKW(P1,2), pw2); \
    VRD(6); SBAR(); GAPA(C1=MF32(kf[5],qr[2],C1),   P1[6],P1[7],P1[8],P1[9],     pw2[2]=PKW(P1,4), pw2[3]=PKW(P1,6), pw2); \
    VRD(3); SBAR(); GAPA(C0=MF32(kf[6],qr[3],C0),   P1[10],P1[11],P1[12],P1[13], pw3[0]=PKW(P1,8), pw3[1]=PKW(P1,10), pw3); \
    VRD(7); SBAR(); GAPA(C1=MF32(kf[7],qr[3],C1),   P1[14],P1[15],0.f,0.f,       pw3[2]=PKW(P1,12),pw3[3]=PKW(P1,14), pw3); \
    l_reg+=sacc; \
    if(GK){DMA_K((t)+3,sl_cur);} if(GV){DMA_V((t)+1,sl_next);} \
    CMASK(C0,C1,t,val_,MK); \
    { float a=MX3(C0[0],C0[1],C1[0]),b=MX3(C0[2],C0[3],C1[1]); a=MX3(a,C1[2],C1[3]); \
      _Pragma("unroll") for(int r=4;r<16;r+=4){a=MX3(a,C0[r],C0[r+1]);b=MX3(b,C0[r+2],C0[r+3]);a=MX3(a,C1[r],C1[r+1]);b=MX3(b,C1[r+2],C1[r+3]);} \
      float rm=__builtin_fmaxf(a,b); { auto rr=__builtin_amdgcn_permlane32_swap(__float_as_uint(rm),__float_as_uint(rm),false,false); rm=__builtin_fmaxf(__uint_as_float(rr[0]),__uint_as_float(rr[1])); } \
      resc=false; \
      if(__builtin_expect(__any(rm>(float)THRL),0)){ const float dl=__builtin_fmaxf(rm,0.f); mhat+=dl; \
        _Pragma("unroll") for(int r=0;r<16;++r){C0[r]-=dl;C1[r]-=dl;} \
        SETQX(); \
        const float f=__builtin_amdgcn_exp2f(-dl); l_reg*=f; if(hi==0)wsf[r32]=f; resc=true; } } \
    SBAR(); \
    GAPB(o[0]=MF32(PAF(0),VFR(0),o[0]), C0,0); \
    GAPB(o[1]=MF32(PAF(0),VFR(4),o[1]), C0,4); \
    KRD(GL,0); GAPB(o[0]=MF32(PAF(1),VFR(1),o[0]), C0,8); \
    KRD(GL,1); GAPB(o[1]=MF32(PAF(1),VFR(5),o[1]), C0,12); \
    KRD(GL,2); GAPB(o[0]=MF32(PAF(2),VFR(2),o[0]), C1,0); \
    KRD(GL,3); GAPB(o[1]=MF32(PAF(2),VFR(6),o[1]), C1,4); \
    GAPB(o[0]=MF32(PAF(3),VFR(3),o[0]), C1,8); \
    GAPB(o[1]=MF32(PAF(3),VFR(7),o[1]), C1,12); \
    if(GL){ BUILDKX((t)+1); } \
    }while(0)
  int t=1; bool early=false;
  for(;t+5<NT;t+=2){
    STEP(pB0,pB1,pA0,pA1,t,true,true,true,false);     WAIT_BAR(2); RESC(); ROT();
    STEP(pA0,pA1,pB0,pB1,t+1,true,true,true,false);
    if constexpr(MODE==0){ if(t>=3){ const float Bn=-*(const __attribute__((address_space(3))) float*)(shm3+LDS_X+(64*(NT-3-t)+63)*4); const bool c_=(ub+Bn-mhat)<-160.f; const bool a_=__all(c_); if(lane==0)votes[wid]=a_?1u:0u; } }
    WAIT_BAR(2); RESC(); ROT();
    if constexpr(MODE==0){ if(t>=3){ const unsigned v_=votes[0]&votes[1]&votes[2]&votes[3]&votes[4]&votes[5]&votes[6]&votes[7]; if(__builtin_amdgcn_readfirstlane(v_)!=0u){ early=true; break; } } }
  }
  if(!early){
  #define ENDW(tt) do{ if((tt)+3<NT){WAIT_BAR(2);} else if((tt)+2<NT){WAIT_BAR(1);} else {WAIT_BAR(0);} }while(0)
  for(;t+1<NT;t+=2){
    STEP(pB0,pB1,pA0,pA1,t,(t+3<NT),(t+1<NT),(t+1<NT),true);       ENDW(t);   RESC(); ROT();
    STEP(pA0,pA1,pB0,pB1,t+1,(t+4<NT),(t+2<NT),(t+2<NT),true);     ENDW(t+1); RESC(); ROT();
  }
  STEP(pB0,pB1,pA0,pA1,NT-1,false,false,false,true); RESC();
  } else { pB0=pA0; pB1=pA1; }
  const int sl_d=early?sl_prev:sl_cur;
  { float sacc=pB0[0]+pB0[1]; _Pragma("unroll") for(int r=2;r<16;++r)sacc+=pB0[r]; _Pragma("unroll") for(int r=0;r<16;++r)sacc+=pB1[r]; l_reg+=sacc;
    pw0=(u32x4){PKW(pB0,0),PKW(pB0,2),PKW(pB0,4),PKW(pB0,6)};pw1=(u32x4){PKW(pB0,8),PKW(pB0,10),PKW(pB0,12),PKW(pB0,14)};pw2=(u32x4){PKW(pB1,0),PKW(pB1,2),PKW(pB1,4),PKW(pB1,6)};pw3=(u32x4){PKW(pB1,8),PKW(pB1,10),PKW(pB1,12),PKW(pB1,14)};
    SBAR(); pv(o,vb0+sl_d,PAF(0),PAF(1),PAF(2),PAF(3)); }
  if(early) asm volatile("s_waitcnt vmcnt(0)":::"memory");
  #undef PKW
  #undef PAF
  #undef VFR
  #undef PIN
  #undef MX3
  #undef GAPA
  #undef GAPB
  #undef EX
  #undef VRD
  #undef KRD
  #undef STEP
  #undef ENDW
  {auto rr=__builtin_amdgcn_permlane32_swap(__float_as_uint(l_reg),__float_as_uint(l_reg),false,false);l_reg=__uint_as_float(rr[0])+__uint_as_float(rr[1]);}
  if(hi==0)wsf[32+r32]=l_reg;asm volatile("s_waitcnt lgkmcnt(0)":::"memory");
  float rli[16];
  #pragma unroll
  for(int r=0;r<16;++r)rli[r]=__builtin_amdgcn_rcpf(wsf[32+crow(r,hi)]);
  bf16*Ow=O+(rowbase+q0+wid*QBLK)*DM+h*D;
  { bf16*stg=(bf16*)(shm+LDS_OST)+wid*2048;
    #pragma unroll
    for(int r=0;r<16;++r){const int orow=crow(r,hi);
      #pragma unroll
      for(int d0=0;d0<2;++d0)stg[orow*64+d0*32+r32]=__float2bfloat16(o[d0][r]*rli[r]);}
    asm volatile("s_waitcnt lgkmcnt(0)":::"memory");
    #pragma unroll
    for(int i=0;i<4;++i){const int row=i*8+(lane>>3),ch=lane&7; const u32x4 v=*(const u32x4*)(stg+row*64+ch*8); ATTN_STORE16(Ow+(long)row*DM+ch*8,v);} }
  asm volatile("s_waitcnt lgkmcnt(0)\n\ts_barrier":::"memory");
  #undef DMA_K
  #undef TM
  #undef DMA_V
  #undef CMASK
  #undef CINIT
  #undef BUILDKX
  #undef SETQX
  #undef TVALID
  #undef START
  #undef RESC
  #undef ROT
}
constexpr int ATTN_LDS_BYTES=LDS_BYTES;
#undef SBAR
#undef WAIT_BAR
#undef MF32
}
constexpr int NWAVES = 8;
#ifndef MK_N_LAUNCHES
#define MK_N_LAUNCHES 1
#endif
constexpr int N_PHASES = 18;
constexpr int DMODEL = 1024, NHEADS = 16, HDIM = 64, DFF = 4096, SEQL = 8192, NBATCH = 4, MP = NBATCH * SEQL, MS = 256, MTOT = MP + MS;
constexpr int PAST = 1024, WINC = 512, NREL = 513;
constexpr float L2E = 1.4426950408889634f;
constexpr size_t O_Y = 0, O_BKP = (size_t)MTOT * 1024, O_BVP = O_BKP + 4 * 512 * 1024, O_BKS = O_BVP + 4 * 512 * 1024, O_BVS = O_BKS + 262144,
                 O_FKP = O_BVS + 262144, O_FVP = O_FKP + (size_t)MP * 1024, O_FLP = O_FVP + (size_t)MP * 1024, O_FKS = O_FLP + (size_t)MP * 16, O_FVS = O_FKS + 262144, O_FLS = O_FVS + 262144, O_END = O_FLS + 4096;
constexpr size_t MiB = 1u << 20;
constexpr size_t WS_CTL = 0, CTL_ZERO_BYTES = 1 * MiB;
constexpr size_t WS_ROWSS = 1 * MiB;
constexpr size_t WS_BTOT = WS_ROWSS + 7 * (size_t)MTOT * 4;
constexpr size_t WS_CS2 = 2 * MiB;
constexpr size_t WS_W = 4 * MiB, W_LAYER = 57 * MiB;
constexpr size_t W_GUA = 0, W_DA = 16 * MiB, W_QKV = 24 * MiB, W_O = 31 * MiB, W_GUB = 33 * MiB, W_DB = 49 * MiB;
constexpr size_t WS_XG = 118 * MiB;
constexpr size_t WS_ACT = 183 * MiB;
constexpr size_t WS_QO = 183 * MiB, WS_KB = 248 * MiB, WS_VB = 313 * MiB;
constexpr size_t WS_OB = 441 * MiB;
constexpr size_t WS_END = 506 * MiB;
static_assert(WS_BTOT + 128 * 16 * 4 <= WS_CS2 && WS_ACT + (size_t)MTOT * 4096 * 2 <= WS_OB && WS_OB + (size_t)MTOT * 2048 <= WS_END && WS_XG + (size_t)MTOT * 2048 <= WS_ACT && WS_W + 2 * W_LAYER <= WS_XG, "ws map");
constexpr int CW_BAR = 4096, CW_QUEUE = 16384;
constexpr int RING_OFF = 0, RING_BYTES = 131072;
constexpr int LDSCTL_OFF = RING_BYTES, MISC_OFF = LDSCTL_OFF + 320;
constexpr int LDS_BYTES = 147456;
static_assert(attn_body::ATTN_LDS_BYTES + 64 <= RING_BYTES, "attention LDS");

#define GAS __attribute__((address_space(1)))
#define LAS __attribute__((address_space(3)))
typedef unsigned short bf16;
typedef unsigned v4u __attribute__((ext_vector_type(4)));
typedef float f32x4 __attribute__((ext_vector_type(4)));
typedef short bf16x8 __attribute__((ext_vector_type(8)));
typedef GAS unsigned gu32;
#define RLX_AGENT __ATOMIC_RELAXED, __HIP_MEMORY_SCOPE_AGENT
#define LDS_WAIT() asm volatile("s_waitcnt lgkmcnt(0)" ::: "memory")
#define VM_WAIT() asm volatile("s_waitcnt vmcnt(0)" ::: "memory")
__device__ __forceinline__ unsigned f2bf(float f) { unsigned u = __builtin_bit_cast(unsigned, f); return (u + 0x7fffu + ((u >> 16) & 1u)) >> 16; }
__device__ __forceinline__ unsigned pk2(float lo, float hi) { return f2bf(lo) | (f2bf(hi) << 16); }
__device__ __forceinline__ float bf2f(unsigned short b) { return __builtin_bit_cast(float, (unsigned)b << 16); }
struct QkvOff { static constexpr size_t o_qo = WS_QO, o_kb = WS_KB, o_vb = WS_VB, o_rowss0 = WS_ROWSS, o_btot = WS_BTOT, o_bkp = O_BKP, o_bvp = O_BVP, o_bks = O_BKS, o_bvs = O_BVS,
    o_fkp = O_FKP, o_fvp = O_FVP, o_fks = O_FKS, o_fvs = O_FVS, o_flp = O_FLP, o_fls = O_FLS; static constexpr int mtot = MTOT; };
#define XB_TMO      128
#define XB_XCNT(j)  (256  + 64 * (j))
#define XB_XSUB(j)  (1280 + 64 * (j))
#define XB_XGEN(j)  (2304 + 64 * (j))
#define XB_TOP      3328
#define XB_TOPGEN   3392
#define XCD_BAR_WORDS 3456
#define XB_SPIN_CAP (1u << 18)

__device__ __forceinline__ unsigned xb_ld(unsigned* p)              { return __hip_atomic_load(p, __ATOMIC_RELAXED, __HIP_MEMORY_SCOPE_AGENT); }
__device__ __forceinline__ unsigned xb_add(unsigned* p, unsigned v) { return __hip_atomic_fetch_add(p, v, __ATOMIC_RELAXED, __HIP_MEMORY_SCOPE_AGENT); }
__device__ __forceinline__ unsigned xb_xcc_id() { return (unsigned)__builtin_amdgcn_s_getreg((3 << 11) | 20) & 0xFu; }
#define XB_SPIN(cond, bar) do { unsigned _sp = 0; while (cond) { __builtin_amdgcn_s_sleep(1); \
    if ((++_sp & 255u) == 0u) { if (xb_ld(&(bar)[XB_TMO])) break; if (_sp > XB_SPIN_CAP) { atomicAdd(&(bar)[XB_TMO], 1u); break; } } } } while (0)

struct XcdBarrier {
    unsigned* bar; unsigned x;
    volatile LAS unsigned* st;
};

__device__ __forceinline__ XcdBarrier xcd_barrier_post(unsigned* bar, volatile LAS unsigned* st) {
    XcdBarrier b; b.bar = bar; b.x = xb_xcc_id(); b.st = st;
    if (threadIdx.x == 0) (void)xb_add(&bar[XB_XCNT(b.x)], 1u);
    return b;
}
__device__ __forceinline__ void xcd_barrier_complete(unsigned* bar, unsigned x, unsigned& nloc, unsigned& nx) {
    const unsigned G = gridDim.x * gridDim.y * gridDim.z;
    unsigned sum, cnt, mine, sp = 0u;
    for (;;) {
        sum = 0u; cnt = 0u; mine = 0u;
#pragma unroll
        for (unsigned j = 0; j < 16; ++j) { const unsigned c = xb_ld(&bar[XB_XCNT(j)]); sum += c; cnt += (c > 0u) ? 1u : 0u; mine = (j == x) ? c : mine; }
        if (sum == G) break;
        __builtin_amdgcn_s_sleep(1);
        if ((++sp & 255u) == 0u) { if (xb_ld(&bar[XB_TMO])) break; if (sp > XB_SPIN_CAP) { atomicAdd(&bar[XB_TMO], 1u); break; } }
    }
    nloc = mine > 0u ? mine : 1u; nx = cnt > 0u ? cnt : 1u;
}

__device__ __forceinline__ void xcd_barrier(const XcdBarrier& b) {
    asm volatile("s_waitcnt vmcnt(0)" ::: "memory");
    __syncthreads();
    if (threadIdx.x == 0) {
        unsigned* bar = b.bar;
        __builtin_amdgcn_s_waitcnt(0);
        unsigned nloc = b.st[0], nx = b.st[1];
        if (nloc == 0u) { xcd_barrier_complete(bar, b.x, nloc, nx); b.st[0] = nloc; b.st[1] = nx; }
        const unsigned old = xb_add(&bar[XB_XSUB(b.x)], 1u);
        const unsigned gen = old / nloc;
        if (old + 1u == (gen + 1u) * nloc) {
            __builtin_amdgcn_fence(__ATOMIC_RELEASE, "agent");
            asm volatile("s_waitcnt vmcnt(0)" ::: "memory");
            const unsigned og = xb_add(&bar[XB_TOP], 1u);
            const unsigned tg = og / nx;
            if (og + 1u == (tg + 1u) * nx) xb_add(&bar[XB_TOPGEN], 1u);
            else XB_SPIN(xb_ld(&bar[XB_TOPGEN]) == tg, bar);
            __builtin_amdgcn_fence(__ATOMIC_ACQUIRE, "agent");
            xb_add(&bar[XB_XGEN(b.x)], 1u);
            asm volatile("s_waitcnt vmcnt(0)" ::: "memory");
        } else {
            XB_SPIN(xb_ld(&bar[XB_XGEN(b.x)]) == gen, bar);
            __builtin_amdgcn_fence(__ATOMIC_ACQUIRE, "agent");
            asm volatile("s_waitcnt vmcnt(0)" ::: "memory");
        }
    }
    __syncthreads();
}

__device__ __forceinline__ float wave_sum(float v) {
#pragma unroll
    for (int o = 1; o < 64; o <<= 1) v += __shfl_xor(v, o);
    return v;
}
struct TrItem { const float* W; bf16* WT; const float* g; int K, N, mode, item; };
__device__ __forceinline__ void tr_load(const TrItem& t, int lane, f32x4 (&v)[8]) {
    const int nblk = t.N / 32, kb = t.item / nblk, nb = t.item % nblk, k0 = 64 * kb, n0 = 32 * nb;
#pragma unroll
    for (int i = 0; i < 8; ++i) { const int kk = 8 * i + (lane >> 3), n4 = (lane & 7) * 4; v[i] = *(const f32x4*)(t.W + (size_t)(k0 + kk) * t.N + n0 + n4); }
}
__device__ __forceinline__ void tr_finish(const TrItem& t, int lane, const f32x4 (&v)[8], LAS float* scr) {
    const int nblk = t.N / 32, kb = t.item / nblk, nb = t.item % nblk, k0 = 64 * kb, n0 = 32 * nb;
    const int drow = (t.mode == 0) ? n0 : ((n0 >> 7) * 256 + (n0 & 127) + (t.mode == 2 ? 128 : 0));
#pragma unroll
    for (int i = 0; i < 8; ++i) { const int kk = 8 * i + (lane >> 3), n4 = (lane & 7) * 4; const float gk = t.g ? t.g[k0 + kk] : 1.0f;
        scr[kk * 33 + n4] = v[i].x * gk; scr[kk * 33 + n4 + 1] = v[i].y * gk; scr[kk * 33 + n4 + 2] = v[i].z * gk; scr[kk * 33 + n4 + 3] = v[i].w * gk; }
    LDS_WAIT(); asm volatile("" ::: "memory");
    const int c = lane & 7;
#pragma unroll
    for (int j = 0; j < 4; ++j) { const int n = (lane >> 3) + 8 * j; const LAS float* s = scr + (8 * c) * 33 + n;
        v4u o; o.x = pk2(s[0 * 33], s[1 * 33]); o.y = pk2(s[2 * 33], s[3 * 33]); o.z = pk2(s[4 * 33], s[5 * 33]); o.w = pk2(s[6 * 33], s[7 * 33]);
        *(GAS v4u*)(t.WT + (size_t)(drow + n) * t.K + k0 + 8 * c) = o; }
    LDS_WAIT(); asm volatile("" ::: "memory");
}

struct Args { const float* in[17]; float* out; unsigned char* ws; int ph_lo, ph_hi, coop, pad; };
#define CAS __attribute__((address_space(4)))
typedef const float* const CAS* kin_t;
struct KA { kin_t in; float* out; unsigned char* ws; };
__device__ __forceinline__ KA get_ka() { const CAS char* kp = (const CAS char*)__builtin_amdgcn_kernarg_segment_ptr(); asm volatile("" : "+s"(kp));
    KA a; a.in = (kin_t)kp; a.out = *(float* const CAS*)((const CAS char*)kp + 136); a.ws = *(unsigned char* const CAS*)((const CAS char*)kp + 144); return a; }
static_assert(offsetof(Args, out) == 136 && offsetof(Args, ws) == 144, "Args layout");

__device__ __forceinline__ void p0_prologue(const KA& A, LAS unsigned char* lds, int gw, int NGW, int wave, int lane) {
    LAS float* scr = (LAS float*)(lds + wave * 16384);
    constexpr int I_G = 2048, I_D = 2048, I_Q = 1536, I_O = 512, PER_LAYER = 4 * I_G + 2 * I_D + I_Q + I_O;
    auto decode = [&](int it) -> TrItem { TrItem t; const int l = it / PER_LAYER; int r = it - l * PER_LAYER; unsigned char* wl = A.ws + WS_W + (size_t)l * W_LAYER;
        if (r < 4 * I_G) { const int w = r / I_G, j = w >> 1, up = w & 1; r -= w * I_G;
            t.W = A.in[up ? 11 : 10] + (size_t)(l * 2 + j) * 1024 * 4096; t.g = A.in[7] + (size_t)(3 * l + 2 * j) * 1024; t.K = 1024; t.N = 4096; t.WT = (bf16*)(wl + (j ? W_GUB : W_GUA)); t.mode = 1 + up; t.item = r; return t; }
        r -= 4 * I_G;
        if (r < 2 * I_D) { const int j = r / I_D; r -= j * I_D; t.W = A.in[12] + (size_t)(l * 2 + j) * 4096 * 1024; t.g = nullptr; t.K = 4096; t.N = 1024; t.WT = (bf16*)(wl + (j ? W_DB : W_DA)); t.mode = 0; t.item = r; return t; }
        r -= 2 * I_D;
        if (r < I_Q) { t.W = A.in[8] + (size_t)l * 1024 * 3072; t.g = A.in[7] + (size_t)(3 * l + 1) * 1024; t.K = 1024; t.N = 3072; t.WT = (bf16*)(wl + W_QKV); t.mode = 0; t.item = r; return t; }
        r -= I_Q; t.W = A.in[9] + (size_t)l * 1024 * 1024; t.g = nullptr; t.K = 1024; t.N = 1024; t.WT = (bf16*)(wl + W_O); t.mode = 0; t.item = r; return t; };
    for (int it = gw; it < 2 * PER_LAYER; it += 2 * NGW) {
        const bool two = it + NGW < 2 * PER_LAYER;
        const TrItem t0 = decode(it), t1 = decode(two ? it + NGW : it);
        f32x4 v0[8], v1[8]; tr_load(t0, lane, v0); if (two) tr_load(t1, lane, v1);
        tr_finish(t0, lane, v0, scr); if (two) tr_finish(t1, lane, v1, scr);
    }
    { bf16* wq1 = (bf16*)(A.ws + WS_W + W_LAYER + W_QKV) + (size_t)3072 * 1024; const float* wf = A.in[14];
      for (int i = gw * 64 + lane; i < 256 * 1024; i += NGW * 64) { const int n = i >> 10, k = i & 1023; wq1[i] = (n < 16) ? (bf16)f2bf(wf[k * 16 + n] * A.in[7][4 * 1024 + k]) : (bf16)0; } }
    float* rowss = (float*)(A.ws + WS_ROWSS); float* x = A.out; bf16* xg = (bf16*)(A.ws + WS_XG); const float* g0 = A.in[7];
    f32x4 gv[4];
#pragma unroll
    for (int j = 0; j < 4; ++j) gv[j] = *(const f32x4*)(g0 + 4 * lane + 256 * j);
    for (int m0 = gw; m0 < MTOT; m0 += 2 * NGW) {
        f32x4 v[2][4]; const bool two = m0 + NGW < MTOT;
#pragma unroll
        for (int q = 0; q < 2; ++q) { const int m = (q && two) ? m0 + NGW : m0; const float* src = (m < MP) ? A.in[0] + (size_t)m * 1024 : A.in[1] + (size_t)(m - MP) * 1024;
#pragma unroll
            for (int j = 0; j < 4; ++j) v[q][j] = *(const f32x4*)(src + 4 * lane + 256 * j); }
#pragma unroll
        for (int q = 0; q < 2; ++q) { if (q && !two) break; const int m = q ? m0 + NGW : m0; float s = 0.f;
#pragma unroll
            for (int j = 0; j < 4; ++j) s += (v[q][j].x * v[q][j].x + v[q][j].y * v[q][j].y) + (v[q][j].z * v[q][j].z + v[q][j].w * v[q][j].w);
            s = wave_sum(s);
#pragma unroll
            for (int j = 0; j < 4; ++j) { const f32x4 a = v[q][j];
                *(unsigned long long*)(xg + (size_t)m * 1024 + 4 * lane + 256 * j) = (unsigned long long)pk2(a.x, a.y) | ((unsigned long long)pk2(a.z, a.w) << 32); }
            if (lane == 0) rowss[m] = s; }
    }
    for (int i = gw * 64 + lane; i < 6 * MTOT + 128 * 16 + 64; i += NGW * 64) rowss[MTOT + i] = 0.f;
}


typedef float f32x4s __attribute__((ext_vector_type(4)));
template <int NB> __device__ __forceinline__ void skinny_mma(const bf16* A, const bf16* B0, const bf16* B1, int K, int wave, int lane, LAS unsigned char* lds, f32x4s (&acc)[NB]) {
    const int fr = lane & 15, fq = lane >> 4, rf = wave & 3, kh = wave >> 2, KH = K >> 1;
    const bf16* ap = A + (size_t)(16 * rf + fr) * K + kh * KH + 8 * fq;
    const bf16* bp0 = B0 + (size_t)fr * K + kh * KH + 8 * fq; const bf16* bp1 = (NB == 2) ? B1 + (size_t)fr * K + kh * KH + 8 * fq : bp0;
#pragma unroll
    for (int nb = 0; nb < NB; ++nb) acc[nb] = (f32x4s){0.f, 0.f, 0.f, 0.f};
    constexpr int U = 16;
#pragma unroll 1
    for (int k0 = 0; k0 < KH; k0 += 32 * U) { bf16x8 av[U], bv[U][NB];
#pragma unroll
        for (int s = 0; s < U; ++s) { av[s] = *(const bf16x8*)(ap + k0 + 32 * s); bv[s][0] = *(const bf16x8*)(bp0 + k0 + 32 * s); if (NB == 2) bv[s][1] = *(const bf16x8*)(bp1 + k0 + 32 * s); }
#pragma unroll
        for (int s = 0; s < U; ++s)
#pragma unroll
            for (int nb = 0; nb < NB; ++nb) acc[nb] = __builtin_amdgcn_mfma_f32_16x16x32_bf16(av[s], bv[s][nb], acc[nb], 0, 0, 0); }
    LAS f32x4s* red = (LAS f32x4s*)lds;
    if (kh == 1) {
#pragma unroll
        for (int nb = 0; nb < NB; ++nb) red[(rf * 64 + lane) * NB + nb] = acc[nb]; }
    __syncthreads();
    if (kh == 0) {
#pragma unroll
        for (int nb = 0; nb < NB; ++nb) acc[nb] += red[(rf * 64 + lane) * NB + nb]; }
    __syncthreads();
}
template <int NB, int NRF> __device__ __forceinline__ void skinny_full(const bf16* A, const bf16* B0, const bf16* B1, int K, int wave, int lane, f32x4s (&acc)[NB][NRF]) {
    const int fr = lane & 15, fq = lane >> 4;
    const bf16* ap = A + (size_t)(16 * NRF * wave + fr) * K + 8 * fq;
    const bf16* bp0 = B0 + (size_t)fr * K + 8 * fq; const bf16* bp1 = (NB == 2) ? B1 + (size_t)fr * K + 8 * fq : bp0;
#pragma unroll
    for (int nb = 0; nb < NB; ++nb)
#pragma unroll
        for (int a = 0; a < NRF; ++a) acc[nb][a] = (f32x4s){0.f, 0.f, 0.f, 0.f};
    constexpr int U = 8;
#pragma unroll 1
    for (int k0 = 0; k0 < K; k0 += 32 * U) { bf16x8 av[U][NRF], bv[U][NB];
#pragma unroll
        for (int s = 0; s < U; ++s) {
#pragma unroll
            for (int a = 0; a < NRF; ++a) av[s][a] = *(const bf16x8*)(ap + (size_t)(16 * a) * K + k0 + 32 * s);
            bv[s][0] = *(const bf16x8*)(bp0 + k0 + 32 * s); if (NB == 2) bv[s][1] = *(const bf16x8*)(bp1 + k0 + 32 * s); }
#pragma unroll
        for (int s = 0; s < U; ++s)
#pragma unroll
            for (int nb = 0; nb < NB; ++nb)
#pragma unroll
                for (int a = 0; a < NRF; ++a) acc[nb][a] = __builtin_amdgcn_mfma_f32_16x16x32_bf16(av[s][a], bv[s][nb], acc[nb][a], 0, 0, 0); }
}
__device__ __forceinline__ void skinny_gateup(const KA& A, LAS unsigned char* lds, int G, int bx, int wave, int lane, const bf16* Wgu, const float* rowss) {
    const bf16* XG = (const bf16*)(A.ws + WS_XG) + (size_t)MP * 1024; bf16* ACT = (bf16*)(A.ws + WS_ACT);
    const int fr = lane & 15, fq = lane >> 4;
    for (int sl = bx; sl < 256; sl += G) { const int c0 = 16 * sl; const int brow = (c0 >> 7) * 256 + (c0 & 127);
        f32x4s acc[2][2]; skinny_full<2, 2>(XG, Wgu + (size_t)brow * 1024, Wgu + (size_t)(brow + 128) * 1024, 1024, wave, lane, acc);
#pragma unroll
        for (int a = 0; a < 2; ++a)
#pragma unroll
            for (int i = 0; i < 4; ++i) { const int row = MP + 16 * (2 * wave + a) + 4 * fq + i; const float rs = pg8::rstd_of(rowss[row]);
                ACT[(size_t)row * 4096 + c0 + fr] = (bf16)f2bf(pg8::silu_mul(acc[0][a][i] * rs, acc[1][a][i] * rs)); } }
}
__device__ __forceinline__ void skinny_resid(const KA& A, const float* xin32  , LAS unsigned char* lds, int G, int bx, int wave, int lane, const bf16* Ain, int K, const bf16* Wt, bf16* xb, float* rowss_next, float alpha) {
    const int fr = lane & 15, fq = lane >> 4, rf = wave & 3;
    for (int it = bx; it < 256; it += G) { const int sl = it >> 2, rg = it & 3, c0 = 16 * sl;
        f32x4s acc[1]; skinny_mma<1>(Ain + (size_t)(MP + 64 * rg) * K, Wt + (size_t)c0 * K, nullptr, K, wave, lane, lds, acc);
        if (wave < 4) {
#pragma unroll
            for (int i = 0; i < 4; ++i) { const int row = MP + 64 * rg + 16 * rf + 4 * fq + i; const size_t o = (size_t)row * 1024 + c0 + fr;
                const float v = (xin32 ? xin32[o] : bf2f(xb[o])) + alpha * acc[0][i]; xb[o] = (bf16)f2bf(v);
                float ss = v * v; ss += __shfl_xor(ss, 1); ss += __shfl_xor(ss, 2); ss += __shfl_xor(ss, 4); ss += __shfl_xor(ss, 8);
                if (fr == 0) __hip_atomic_fetch_add(rowss_next + row, ss, __ATOMIC_RELAXED, __HIP_MEMORY_SCOPE_AGENT); } } }
}
__device__ __forceinline__ void skinny_qkv(const KA& A, LAS unsigned char* lds, int G, int bx, int wave, int lane, const bf16* Wqkv, const float* rowss, int fox) {
    const bf16* XG = (const bf16*)(A.ws + WS_XG) + (size_t)MP * 1024;
    const int fr = lane & 15, fq = lane >> 4;
    for (int sl = bx; sl < 192; sl += G) { const int c0 = 16 * sl;
        f32x4s acc[1][2]; skinny_full<1, 2>(XG, Wqkv + (size_t)c0 * 1024, nullptr, 1024, wave, lane, acc);
        const int t = sl >> 6, cin = c0 - 1024 * t + fr; bf16* bd = (bf16*)(A.ws + (t == 0 ? WS_QO : t == 1 ? WS_KB : WS_VB));
#pragma unroll
        for (int a = 0; a < 2; ++a)
#pragma unroll
            for (int i = 0; i < 4; ++i) { const int rl = 16 * (2 * wave + a) + 4 * fq + i, row = MP + rl; const float v = acc[0][a][i] * pg8::rstd_of(rowss[row]);
                bd[(size_t)row * 1024 + cin] = (bf16)f2bf(t == 0 ? v * attn_body::C2 : v);
                if (t == 1) A.out[(fox ? O_FKS : O_BKS) + (size_t)rl * 1024 + cin] = v; else if (t == 2) A.out[(fox ? O_FVS : O_BVS) + (size_t)rl * 1024 + cin] = v; } }
}
__device__ __forceinline__ void skinny_logf(const KA& A, LAS unsigned char* lds, int G, int bx, int wave, int lane, const bf16* Wf  , const float* rowss) {
    const bf16* XG = (const bf16*)(A.ws + WS_XG); float* blocktot = (float*)(A.ws + WS_BTOT);
    const int fr = lane & 15, fq = lane >> 4; const float bfr = A.in[15][fr];
    for (int it = bx; it < MTOT / 128; it += G) {
        f32x4s acc[1][1]; skinny_full<1, 1>(XG + (size_t)(128 * it) * 1024, Wf, nullptr, 1024, wave, lane, acc);
        float tot = 0.f;
#pragma unroll
        for (int i = 0; i < 4; ++i) { const int row = 128 * it + 16 * wave + 4 * fq + i; const float z = acc[0][0][i] * pg8::rstd_of(rowss[row]) + bfr; const float ee = __builtin_amdgcn_exp2f(-L2E * fabsf(z));
            const float big = 0.6931471805599453f * __builtin_amdgcn_logf(1.0f + ee), sm = ee * (1.0f - ee * (0.5f - ee * (0.3333333333f - 0.25f * ee)));
            const float lfv = fminf(z, 0.f) - (ee < 0.03f ? sm : big); tot += lfv;
            if (row < MP) A.out[O_FLP + (size_t)row * 16 + fr] = lfv; else A.out[O_FLS + (size_t)(row - MP) * 16 + fr] = lfv; }
        tot += __shfl_xor(tot, 16); tot += __shfl_xor(tot, 32);
        if (fq == 0 && it < MP / 128) __hip_atomic_fetch_add(blocktot + (it >> 1) * 16 + fr, tot, __ATOMIC_RELAXED, __HIP_MEMORY_SCOPE_AGENT); }
}
template <int FOX> __device__ __forceinline__ void sample_unit(int s, int h, LAS unsigned char* lds, const KA& A) {
    constexpr int NC = FOX ? 1024 : 512, NK = NC + 16, SP = 1056;
    int tid_ = threadIdx.x; asm volatile("" : "+v"(tid_)); const int tid = tid_, lane = tid & 63, wave = tid >> 6;
    LAS float* Qs = (LAS float*)lds;
    LAS float* cum = (LAS float*)(lds + 4096);
    LAS float* linv = (LAS float*)(lds + 8320);
    LAS float* S = (LAS float*)(lds + 8448);
    bf16* QO = (bf16*)(A.ws + WS_QO);
    const float* ck = A.in[FOX ? 4 : 2]; const float* cv = A.in[FOX ? 5 : 3];
    const float* nk = A.out + (FOX ? O_FKS : O_BKS); const float* nv = A.out + (FOX ? O_FVS : O_BVS);
    { const int e = tid * 2, i = e >> 6, d = e & 63; const unsigned w = *(const unsigned*)(QO + (size_t)(MP + s * 16 + i) * 1024 + h * 64 + d);
      Qs[i * 64 + d] = bf2f((unsigned short)(w & 0xffffu)); Qs[i * 64 + d + 1] = bf2f((unsigned short)(w >> 16)); }
    if (FOX && wave == 0) { const float* clf = A.in[6]; const float* nlf = A.out + O_FLS; float carry = 0.f;
        for (int c = 0; c < 17; ++c) { const int j = c * 64 + lane;
            float v = (j < 1024) ? clf[(size_t)(s * 1024 + j) * 16 + h] : ((j < 1040) ? nlf[(size_t)(s * 16 + j - 1024) * 16 + h] : 0.f);
#pragma unroll
            for (int d = 1; d < 64; d <<= 1) { const float t = __shfl_up(v, d); if (lane >= d) v += t; }
            v += carry; if (j < 1040) cum[j] = v; carry = __shfl(v, 63); } }
    __syncthreads();
    const float* relb = A.in[13] + h;
    for (int j = tid; j < NK; j += 512) {
        const float* kp = (j < NC) ? ck + ((size_t)(s * NC + j) * 16 + h) * 64 : nk + (size_t)(s * 16 + j - NC) * 1024 + h * 64;
        f32x4 kr[16];
#pragma unroll
        for (int q = 0; q < 16; ++q) kr[q] = *(const f32x4*)(kp + 4 * q);
        const float cj = FOX ? cum[j] : 0.f;
#pragma unroll 1
        for (int i = 0; i < 16; ++i) { float a = 0.f;
#pragma unroll
            for (int q = 0; q < 16; ++q) { const f32x4 qv = *(const LAS f32x4*)(Qs + i * 64 + 4 * q); a += (qv.x * kr[q].x + qv.y * kr[q].y) + (qv.z * kr[q].z + qv.w * kr[q].w); }
            float bias; bool valid = true;
            if (FOX) { bias = L2E * (cum[NC + i] - cj); valid = (j <= NC + i); }
            else { int dist = 512 + i - j; dist = dist > 256 ? 256 : dist; dist = dist < -256 ? -256 : dist; bias = L2E * relb[(dist + 256) * 16]; }
            S[i * SP + j] = valid ? a + bias : -INFINITY; }
    }
    __syncthreads();
#pragma unroll 1
    for (int rr = 0; rr < 2; ++rr) { const int i = wave * 2 + rr; float m = -INFINITY;
        for (int j = lane; j < NK; j += 64) m = fmaxf(m, S[i * SP + j]);
#pragma unroll
        for (int o = 1; o < 64; o <<= 1) m = fmaxf(m, __shfl_xor(m, o));
        float l = 0.f;
        for (int j = lane; j < NK; j += 64) { const float p = __builtin_amdgcn_exp2f(S[i * SP + j] - m); S[i * SP + j] = p; l += p; }
        l = wave_sum(l); if (lane == 0) linv[i] = 1.0f / l; }
    __syncthreads();
    {
      LAS float* red = (LAS float*)(lds + 8448 + 16 * SP * 4);
      float o[16];
#pragma unroll
      for (int i = 0; i < 16; ++i) o[i] = 0.f;
#pragma unroll 8
      for (int j = wave; j < NK; j += 8) { const float v = (j < NC) ? cv[((size_t)(s * NC + j) * 16 + h) * 64 + lane] : nv[(size_t)(s * 16 + j - NC) * 1024 + h * 64 + lane];
#pragma unroll
          for (int i = 0; i < 16; ++i) o[i] += S[i * SP + j] * v; }
#pragma unroll
      for (int i = 0; i < 16; ++i) red[(wave * 16 + i) * 64 + lane] = o[i];
      __syncthreads();
#pragma unroll
      for (int rr = 0; rr < 2; ++rr) { const int i = wave * 2 + rr; float a = 0.f;
#pragma unroll
          for (int w = 0; w < 8; ++w) a += red[(w * 16 + i) * 64 + lane];
          ((bf16*)(A.ws + WS_OB))[(size_t)(MP + s * 16 + i) * 1024 + h * 64 + lane] = (bf16)f2bf(a * linv[i]); } }
    __syncthreads();
}

__device__ __forceinline__ void cumsum_phase(const KA& A, LAS unsigned char* lds, int G) {
    int tid_ = threadIdx.x; asm volatile("" : "+v"(tid_)); const int tid = tid_, h = tid & 15, j = tid >> 4;
    LAS float* tot = (LAS float*)lds;
    const float* lf = A.out + O_FLP; const float* bt = (const float*)(A.ws + WS_BTOT); float* cs2 = (float*)(A.ws + WS_CS2);
    {
        const bf16* KBp = (const bf16*)(A.ws + WS_KB); unsigned* kmax2 = (unsigned*)(A.ws + WS_BTOT) + 2048;
        const int lane = tid & 63, gw = blockIdx.x * NWAVES + (tid >> 6), NGW = G * NWAVES, b = gw & 3; float mx = 0.f;
#pragma unroll 4
        for (int r = gw >> 2; r < SEQL; r += (NGW >> 2)) { const bf16* kr = KBp + (size_t)(b * SEQL + r) * 1024 + 16 * lane; const bf16x8 v0 = *(const bf16x8*)kr, v1 = *(const bf16x8*)(kr + 8); float s2 = 0.f;
#pragma unroll
            for (int j = 0; j < 8; ++j) { const float f0 = bf2f((unsigned short)v0[j]), f1 = bf2f((unsigned short)v1[j]); s2 += f0 * f0 + f1 * f1; }
            s2 += __shfl_xor(s2, 1); s2 += __shfl_xor(s2, 2); mx = fmaxf(mx, s2); }
        if ((lane & 3) == 0) __hip_atomic_fetch_max(kmax2 + b * 16 + (lane >> 2), __float_as_uint(mx), __ATOMIC_RELAXED, __HIP_MEMORY_SCOPE_AGENT);
    }
    for (int it = blockIdx.x; it < 128; it += G) { const int b = it >> 5, seg = it & 31;
        float base = 0.f; for (int s2 = 0; s2 < seg; ++s2) base += bt[(b * 32 + s2) * 16 + h];
        const int t0 = seg * 256 + j * 8; float p[8]; float run = 0.f;
#pragma unroll
        for (int i = 0; i < 8; ++i) { run += lf[(size_t)(b * 8192 + t0 + i) * 16 + h]; p[i] = run; }
        tot[j * 16 + h] = run; __syncthreads();
        float off = base; for (int j2 = 0; j2 < j; ++j2) off += tot[j2 * 16 + h];
        float* dst = cs2 + (size_t)(b * 16 + h) * 8192 + t0;
        *(f32x4*)dst = (f32x4){L2E * (off + p[0]), L2E * (off + p[1]), L2E * (off + p[2]), L2E * (off + p[3])};
        *(f32x4*)(dst + 4) = (f32x4){L2E * (off + p[4]), L2E * (off + p[5]), L2E * (off + p[6]), L2E * (off + p[7])};
        __syncthreads(); }
}

__global__ void __launch_bounds__(NWAVES * 64, 2) mk_fwd(Args args) {
    extern __shared__ __attribute__((aligned(16))) unsigned char lds[];
    LAS unsigned char* lds3 = (LAS unsigned char*)lds;
    volatile LAS unsigned* MISC = (volatile LAS unsigned*)(lds3 + MISC_OFF);
    const int tid0 = threadIdx.x;
    gu32* ctl = (gu32*)(args.ws + WS_CTL);
    for (int u = tid0; u < (LDS_BYTES - LDSCTL_OFF) / 4; u += NWAVES * 64) ((LAS unsigned*)(lds3 + LDSCTL_OFF))[u] = 0u;
    __syncthreads();
    XcdBarrier bar; bar.bar = (unsigned*)(ctl + CW_BAR); bar.x = 0; bar.st = nullptr;
    if (args.coop) bar = xcd_barrier_post((unsigned*)(ctl + CW_BAR), MISC + 8);

    int rep = 0;
    for (int p = args.ph_lo; p < args.ph_hi; ++p) {
        bool did = true;
        const KA A = get_ka();
        int tid_ = threadIdx.x; asm volatile("" : "+v"(tid_)); const int tid = tid_, lane = tid & 63, wave = __builtin_amdgcn_readfirstlane(tid >> 6);
        int G_ = gridDim.x, bx_ = blockIdx.x; asm volatile("" : "+s"(G_), "+s"(bx_)); const int G = G_, bx = bx_; const int vcu = (G % 8 == 0) ? (bx % 8) * (G / 8) + bx / 8 : bx;
        unsigned char* ws = A.ws;
        float* rowss = (float*)(ws + WS_ROWSS);
        bf16* XG = (bf16*)(ws + WS_XG); bf16* ACT = (bf16*)(ws + WS_ACT); bf16* QO = (bf16*)(ws + WS_QO); bf16* KB = (bf16*)(ws + WS_KB); bf16* VB = (bf16*)(ws + WS_VB);
        if (p == 0) {
#ifndef NO_P0
 p0_prologue(A, lds3, vcu * NWAVES + wave, G * NWAVES, wave, lane);
#endif
 }
        else if (p == N_PHASES - 1) {
            const float* gf = A.in[16]; f32x4 gv[4];
#pragma unroll
            for (int j = 0; j < 4; ++j) gv[j] = *(const f32x4*)(gf + 4 * lane + 256 * j);
            for (int m = vcu * NWAVES + wave; m < MTOT; m += G * NWAVES) { const float rs = pg8::rstd_of(rowss[6 * MTOT + m]); float* yr = A.out + (size_t)m * 1024 + 4 * lane; const bf16* xr = XG + (size_t)m * 1024 + 4 * lane;
#pragma unroll
                for (int j = 0; j < 4; ++j) { const unsigned long long w = *(const unsigned long long*)(xr + 256 * j);
                    const f32x4 v = {bf2f((unsigned short)(w & 0xffffu)), bf2f((unsigned short)((w >> 16) & 0xffffu)), bf2f((unsigned short)((w >> 32) & 0xffffu)), bf2f((unsigned short)(w >> 48))};
                    *(f32x4*)(yr + 256 * j) = v * rs * gv[j]; } }
        } else {
            const int l = (p - 1) >> 3, k = (p - 1) & 7;
            unsigned char* wl = ws + WS_W + (size_t)l * W_LAYER;
            if (k == 0 || k == 6) {
                pg8::Gemm g{XG, (const bf16*)(wl + (k ? W_GUB : W_GUA)), MP, 2 * DFF, DMODEL}; pg8::StaticOrder S; S.init(MP, 2 * DFF, G, bx);
                pg8::EpiGateUp E{ACT, rowss + (size_t)(3 * l + (k ? 2 : 0)) * MTOT};

#ifndef NO_GU
pg8::gemm_phase<pg8::EpiGateUp, pg8::StaticOrder, true, true>(lds3 + RING_OFF, g, S, E);
#endif
                skinny_gateup(A, lds3 + RING_OFF, G, bx, wave, lane, (const bf16*)(wl + (k ? W_GUB : W_GUA)), rowss + (size_t)(3 * l + (k ? 2 : 0)) * MTOT);
#ifdef PROBE_SKINNY
                for (int rp_ = 0; rp_ < 4; ++rp_) skinny_gateup(A, lds3 + RING_OFF, G, bx, wave, lane, (const bf16*)(wl + (k ? W_GUB : W_GUA)), rowss + (size_t)(3 * l + (k ? 2 : 0)) * MTOT);
#endif

            } else if (k == 1 || k == 7 || k == 5) {
                const int nn = (k == 1) ? 3 * l + 1 : (k == 5) ? 3 * l + 2 : 3 * l + 3;
                pg8::Gemm g{(k == 5) ? (const bf16*)(ws + WS_OB) : ACT, (const bf16*)(wl + ((k == 1) ? W_DA : (k == 7) ? W_DB : W_O)), MP, DMODEL, (k == 5) ? DMODEL : DFF}; pg8::StaticOrder S; S.init(MP, DMODEL, G, bx);
                if (p == 2) { pg8::EpiResid<true> E{A.in[0], XG, rowss + (size_t)nn * MTOT, (k == 5) ? 1.0f : 0.5f};
#ifndef NO_RES
                    pg8::gemm_phase<pg8::EpiResid<true>, pg8::StaticOrder, true, true>(lds3 + RING_OFF, g, S, E);
#endif
                } else { pg8::EpiResid<false> E{nullptr, XG, rowss + (size_t)nn * MTOT, (k == 5) ? 1.0f : 0.5f};
#ifndef NO_RES
                    pg8::gemm_phase<pg8::EpiResid<false>, pg8::StaticOrder, true, true>(lds3 + RING_OFF, g, S, E);
#endif
                }
                skinny_resid(A, (p == 2) ? A.in[1] - (size_t)MP * 1024 : nullptr, lds3 + RING_OFF, G, bx, wave, lane, (k == 5) ? (const bf16*)(ws + WS_OB) : ACT, (k == 5) ? DMODEL : DFF, (const bf16*)(wl + ((k == 1) ? W_DA : (k == 7) ? W_DB : W_O)), XG, rowss + (size_t)nn * MTOT, (k == 5) ? 1.0f : 0.5f);
            } else if (k == 2) {
                const int N = 3072;
                pg8::Gemm g{XG, (const bf16*)(wl + W_QKV), MP, N, DMODEL}; pg8::StaticOrder S; S.init(MP, N, G, bx);
                pg8::EpiQKV<QkvOff> E{ws, A.out, A.in[15], l, attn_body::C2};

#ifndef NO_QKV
pg8::gemm_phase<pg8::EpiQKV<QkvOff>, pg8::StaticOrder, true, true>(lds3 + RING_OFF, g, S, E);
#endif
                skinny_qkv(A, lds3 + RING_OFF, G, bx, wave, lane, (const bf16*)(wl + W_QKV), rowss + (size_t)(3 * l + 1) * MTOT, l);
                if (l == 1) skinny_logf(A, lds3 + RING_OFF, G, bx, wave, lane, (const bf16*)(wl + W_QKV) + (size_t)3072 * 1024, rowss + (size_t)(3 * l + 1) * MTOT);

            } else if (k == 3) {
                if (l == 1) cumsum_phase(A, lds3, G); else did = false;
            } else {
                const attn_body::bf16* Qb = (const attn_body::bf16*)QO; const attn_body::bf16* Kb = (const attn_body::bf16*)KB; const attn_body::bf16* Vb = (const attn_body::bf16*)VB;
                if (l == 1) {
                    const float* cs2 = (const float*)(ws + WS_CS2); const unsigned* kmax2 = (const unsigned*)(ws + WS_BTOT) + 2048;
                    volatile LAS unsigned* qslot = (volatile LAS unsigned*)(lds3 + RING_OFF + attn_body::ATTN_LDS_BYTES);
#pragma unroll 1
                    for (;;) { if (tid == 0) *qslot = __hip_atomic_fetch_add((unsigned*)(ws + WS_CTL) + CW_QUEUE, 1u, __ATOMIC_RELAXED, __HIP_MEMORY_SCOPE_AGENT);
                        __syncthreads(); const unsigned idx = *qslot; __syncthreads();
                        if (idx >= 2048u + 256u) break;
                        if (idx < 2048u) { const int qb = 31 - (int)(idx >> 6), bh = (int)(idx & 63u);
                            const float kmx = sqrtf(__uint_as_float(__hip_atomic_load(kmax2 + bh, __ATOMIC_RELAXED, __HIP_MEMORY_SCOPE_AGENT))) * 1.01f;
#ifndef NO_FOX
                            attn_body::attn_unit<0, 8>(bh >> 4, bh & 15, qb, Qb, Kb, Vb, (attn_body::bf16*)(ws + WS_OB), (char*)lds + RING_OFF, cs2 + (size_t)bh * 8192, nullptr, kmx);
#endif
                        } else { const int u = (int)idx - 2048;
#ifndef NO_SAMPLE
                            sample_unit<1>(u >> 4, u & 15, lds3 + RING_OFF, A);
#endif
                        } }
                } else {
                    int prev_bh = -1;
#pragma unroll 1
                    for (int u = vcu * (2048 / 256); u < 2048; u += G * (2048 / 256)) {
#pragma unroll 1
                        for (int i = 0; i < 2048 / 256; ++i) { const int bh = (u + i) >> 5, qb = (u + i) & 31;
#ifndef NO_BAND
                            attn_body::attn_unit<1, 8>(bh >> 4, bh & 15, qb, Qb, Kb, Vb, (attn_body::bf16*)(ws + WS_OB), (char*)lds + RING_OFF, nullptr, (bh & 15) == (prev_bh & 15) && prev_bh >= 0 ? nullptr : A.in[13] + (bh & 15), 0.f);
#endif
                            prev_bh = bh; } }
#ifndef NO_SAMPLE
for (int u = bx; u < 256; u += G) sample_unit<0>(u >> 4, u & 15, lds3 + RING_OFF, A);
#endif

                }
            }
        }
        const bool again = (((PROBE_MASK >> p) & 1u) != 0u) && rep == 0;
        if (did && (p + 1 < args.ph_hi || again)) {
            if (p == 0 && !again) { __syncthreads(); cg::this_grid().sync(); } else xcd_barrier(bar);
        }
        if (again) { rep = 1; --p; } else rep = 0;
    }
}

extern "C" void kernel_launch(void* const* d_in, const int* in_sizes, int n_in, void* d_out, int out_size, void* d_ws, size_t ws_size, hipStream_t stream) {
    static int grid = 0;
    if (grid == 0) {
        if (n_in != 17 || out_size != (int)O_END || ws_size < WS_END) { fprintf(stderr, "kernel_launch: unexpected shapes (n_in %d out %d ws %zu)\n", n_in, out_size, ws_size); grid = -1; return; }
        int dev = 0, cus = 0, per_cu = 0;
        if (hipGetDevice(&dev) != hipSuccess || hipDeviceGetAttribute(&cus, hipDeviceAttributeMultiprocessorCount, dev) != hipSuccess) { grid = -1; return; }
        if (hipFuncSetAttribute((const void*)mk_fwd, hipFuncAttributeMaxDynamicSharedMemorySize, LDS_BYTES) != hipSuccess) { fprintf(stderr, "kernel_launch: hipFuncSetAttribute failed\n"); grid = -1; return; }
        if (hipOccupancyMaxActiveBlocksPerMultiprocessor(&per_cu, (const void*)mk_fwd, NWAVES * 64, LDS_BYTES) != hipSuccess || per_cu < 1) { fprintf(stderr, "kernel_launch: occupancy query says %d\n", per_cu); per_cu = 1; }
        (void)hipGetLastError();
        grid = cus * per_cu;
        if (grid > 256) grid = 256;
    }
    if (grid < 0) return;
    if (hipMemsetAsync((char*)d_ws + WS_CTL, 0, CTL_ZERO_BYTES, stream) != hipSuccess) { fprintf(stderr, "kernel_launch: memset failed\n"); return; }
    Args a{};
    for (int i = 0; i < 17; ++i) a.in[i] = (const float*)d_in[i];
    a.out = (float*)d_out; a.ws = (unsigned char*)d_ws; a.pad = 0;
#if MK_N_LAUNCHES == 1
    a.ph_lo = 0; a.ph_hi = N_PHASES; a.coop = 1;
    void* kargs[] = {&a};
    hipError_t e = hipLaunchCooperativeKernel((const void*)mk_fwd, dim3(grid), dim3(NWAVES * 64), kargs, LDS_BYTES, stream);
    if (e != hipSuccess) fprintf(stderr, "kernel_launch: cooperative launch failed: %s (grid %d)\n", hipGetErrorString(e), grid);
#else
    for (int p = 0; p < N_PHASES; ++p) {
        if (p == 4) continue;
        a.ph_lo = p; a.ph_hi = p + 1; a.coop = 0;
        hipLaunchKernelGGL(mk_fwd, dim3(grid), dim3(NWAVES * 64), LDS_BYTES, stream, a);
    }
#endif
}
```

```cpp
#include <hip/hip_runtime.h>
#include <hip/hip_cooperative_groups.h>
#include <hip/hip_bf16.h>
#include <cstdio>
#include <cstdint>
#include <cmath>
namespace cg = cooperative_groups;
#define MK_N_LAUNCHES 1
#define PROBE_MASK 0u
namespace pg8 {
#define PG8_LAS __attribute__((address_space(3)))
typedef unsigned short bf16_t;
typedef short bf16x8 __attribute__((ext_vector_type(8)));
typedef float f32x4 __attribute__((ext_vector_type(4)));
typedef unsigned u32x4 __attribute__((ext_vector_type(4)));
constexpr int BM = 256, BK = 64, HALF = 128, HTB = HALF * BK * 2  , STAGE_BYTES = 8 * HTB, NXCD = 8, WGM = 8;

__host__ __device__ __forceinline__ int lds_byte(int r, int c) { const int st = (r >> 4) * 2 + (c >> 5), rr = r & 15, cc = c & 31, ob = rr * 64 + cc * 2; return st * 1024 + (ob ^ (((ob >> 9) & 1) << 5)); }
__host__ __device__ __forceinline__ void stage_rc(int b, int& R, int& C) { const int st = b / 1024, sb = b % 1024, swz = sb ^ (((sb >> 9) & 1) << 5); R = (st >> 1) * 16 + swz / 64; C = (st & 1) * 32 + (swz % 64) / 2; }
__host__ __device__ __forceinline__ int perm32(int rho) { const int n = rho >> 4, i = rho & 15; return 8 * (i >> 2) + 4 * n + (i & 3); }

struct Unit { int pm, pn; };
struct Gemm { const bf16_t* A; const bf16_t* Bt; int M, N, K; };

struct StaticOrder {
    int nM, nN, nwg, G, c;
    __host__ __device__ void init(int M, int N, int G_, int c_) { nM = M / BM; nN = N / BM; nwg = nM * nN; G = G_; c = c_; }
    __host__ __device__ bool next(int i, Unit& u) const {
        const long L = (long)i * G + c; if (L >= nwg) return false;
        int wgid = (int)L; { const int q = nwg / NXCD, r = nwg % NXCD, xcd = wgid % NXCD, off = wgid / NXCD; wgid = (xcd < r ? xcd * (q + 1) : r * (q + 1) + (xcd - r) * q) + off; }
        const int nig = WGM * nN, gid = wgid / nig, fm = gid * WGM, gsz = (nM - fm) < WGM ? (nM - fm) : WGM;
        u.pm = fm + ((wgid % nig) % gsz); u.pn = (wgid % nig) / gsz; return true;
    }
    __device__ __forceinline__ void a_ready(const Unit&) const {}
    __device__ __forceinline__ void done(const Unit&) const {}
};

__device__ __forceinline__ unsigned cvt_pk_bf16(float lo, float hi) { unsigned r; asm volatile("v_cvt_pk_bf16_f32 %0, %1, %2" : "=v"(r) : "v"(lo), "v"(hi)); return r; }
typedef float f32x2 __attribute__((ext_vector_type(2)));
constexpr float RMS_EPS_F = 1e-6f;
__device__ __forceinline__ float rstd_of(float ss) { return __builtin_amdgcn_rsqf(ss * (1.0f / 1024.0f) + RMS_EPS_F); }
__device__ __forceinline__ float silu_mul(float g, float u) { return g * __builtin_amdgcn_rcpf(1.0f + __builtin_amdgcn_exp2f(-1.4426950408889634f * g)) * u; }

struct EpiGateUp {
    static constexpr bool PERM = true, AFTER_DRAIN = false;
    bf16_t* act; const float* rowss;
    __device__ __forceinline__ void operator()(const f32x4 (&acc)[2][2][4][2], const Unit& u, int wr, int wc, int fr_in, int fq_in) const {
        int fr = fr_in, fq = fq_in; asm volatile("" : "+v"(fr), "+v"(fq));
        const int row0 = u.pm * BM + wr * 64 + fr, col0 = u.pn * HALF + wc * 32 + 8 * fq;
        float ssq[2][4];
#pragma unroll
        for (int ai = 0; ai < 2; ++ai)
#pragma unroll
            for (int m = 0; m < 4; ++m) ssq[ai][m] = rowss[row0 + ai * HALF + m * 16];
        asm volatile("" : "+v"(ssq[0][0]), "+v"(ssq[0][1]), "+v"(ssq[0][2]), "+v"(ssq[0][3]), "+v"(ssq[1][0]), "+v"(ssq[1][1]), "+v"(ssq[1][2]), "+v"(ssq[1][3]));
#pragma unroll
        for (int ai = 0; ai < 2; ++ai)
#pragma unroll
            for (int m = 0; m < 4; ++m) { const int row = row0 + ai * HALF + m * 16; const float rs = rstd_of(ssq[ai][m]);
                const f32x4 g0 = acc[ai][0][m][0] * rs, g1 = acc[ai][0][m][1] * rs, u0 = acc[ai][1][m][0] * rs, u1 = acc[ai][1][m][1] * rs;
                u32x4 w; w.x = cvt_pk_bf16(silu_mul(g0[0], u0[0]), silu_mul(g0[1], u0[1])); w.y = cvt_pk_bf16(silu_mul(g0[2], u0[2]), silu_mul(g0[3], u0[3]));
                w.z = cvt_pk_bf16(silu_mul(g1[0], u1[0]), silu_mul(g1[1], u1[1])); w.w = cvt_pk_bf16(silu_mul(g1[2], u1[2]), silu_mul(g1[3], u1[3]));
                *(u32x4*)(act + (size_t)row * 4096 + col0) = w; }
    }
};

template <bool FIRST> struct EpiResid {
    static constexpr bool PERM = true, AFTER_DRAIN = false;
    const float* xin; bf16_t* xb; float* rowss_next; float alpha;
    __device__ __forceinline__ void operator()(const f32x4 (&acc)[2][2][4][2], const Unit& u, int wr, int wc, int fr_in, int fq_in) const {
        int fr = fr_in, fq = fq_in; asm volatile("" : "+v"(fr), "+v"(fq));
        const int row0 = u.pm * BM + wr * 64 + fr, colb = u.pn * BM + wc * 32 + 8 * fq;
#pragma unroll
        for (int ai = 0; ai < 2; ++ai)
#pragma unroll
          for (int mh = 0; mh < 2; ++mh) {
            f32x4 xv[2][2][2];
#pragma unroll
            for (int mm = 0; mm < 2; ++mm)
#pragma unroll
                for (int bj = 0; bj < 2; ++bj) { const size_t o = (size_t)(row0 + ai * HALF + (2 * mh + mm) * 16) * 1024 + colb + bj * HALF;
                    if constexpr (FIRST) { xv[mm][bj][0] = *(const f32x4*)(xin + o); xv[mm][bj][1] = *(const f32x4*)(xin + o + 4); }
                    else { const u32x4 w = *(const u32x4*)(xb + o);
                        xv[mm][bj][0] = (f32x4){__uint_as_float(w.x << 16), __uint_as_float(w.x & 0xffff0000u), __uint_as_float(w.y << 16), __uint_as_float(w.y & 0xffff0000u)};
                        xv[mm][bj][1] = (f32x4){__uint_as_float(w.z << 16), __uint_as_float(w.z & 0xffff0000u), __uint_as_float(w.w << 16), __uint_as_float(w.w & 0xffff0000u)}; } }
#pragma unroll
            for (int mm = 0; mm < 2; ++mm) asm volatile("" : "+v"(xv[mm][0][0]), "+v"(xv[mm][0][1]), "+v"(xv[mm][1][0]), "+v"(xv[mm][1][1]));
#pragma unroll
            for (int mm = 0; mm < 2; ++mm) { const int m = 2 * mh + mm; const int row = row0 + ai * HALF + m * 16; float ss = 0.f;
#pragma unroll
                for (int bj = 0; bj < 2; ++bj) {
                    const f32x4 v0 = xv[mm][bj][0] + acc[ai][bj][m][0] * alpha, v1 = xv[mm][bj][1] + acc[ai][bj][m][1] * alpha;
                    ss += (v0[0] * v0[0] + v0[1] * v0[1]) + (v0[2] * v0[2] + v0[3] * v0[3]) + (v1[0] * v1[0] + v1[1] * v1[1]) + (v1[2] * v1[2] + v1[3] * v1[3]);
                    u32x4 w; w.x = cvt_pk_bf16(v0[0], v0[1]); w.y = cvt_pk_bf16(v0[2], v0[3]); w.z = cvt_pk_bf16(v1[0], v1[1]); w.w = cvt_pk_bf16(v1[2], v1[3]);
                    *(u32x4*)(xb + (size_t)row * 1024 + colb + bj * HALF) = w; }
                ss += __shfl_xor(ss, 16); ss += __shfl_xor(ss, 32);
                if (fq == 0) __hip_atomic_fetch_add(rowss_next + row, ss, __ATOMIC_RELAXED, __HIP_MEMORY_SCOPE_AGENT); } }
    }
};

template <class C> struct EpiQKV {
    static constexpr bool PERM = true, AFTER_DRAIN = false;
    unsigned char* ws; float* out; const float* bfg; int fox; float qscale;
    __device__ __forceinline__ void operator()(const f32x4 (&acc)[2][2][4][2], const Unit& u, int wr, int wc, int fr_in, int fq_in) const {
        int fr = fr_in, fq = fq_in; asm volatile("" : "+v"(fr), "+v"(fq));
        const int t = u.pn >> 2, row0 = u.pm * BM + wr * 64 + fr;
        const float* rowss = (const float*)(ws + C::o_rowss0) + (size_t)(fox ? 4 : 1) * C::mtot;
        if (t == 3) {
            if (wc == 0 && fq < 2) {
                f32x4 bb[2]; bb[0] = *(const f32x4*)(bfg + 8 * fq); bb[1] = *(const f32x4*)(bfg + 8 * fq + 4);
                f32x4 tot[2] = {(f32x4){0.f, 0.f, 0.f, 0.f}, (f32x4){0.f, 0.f, 0.f, 0.f}};
#pragma unroll
                for (int ai = 0; ai < 2; ++ai)
#pragma unroll
                    for (int m = 0; m < 4; ++m) { const int row = row0 + ai * HALF + m * 16; const float rs = rstd_of(rowss[row]);
                        float* dst = (u.pm == 128) ? out + C::o_fls + (size_t)(row - 32768) * 16 : out + C::o_flp + (size_t)row * 16;
#pragma unroll
                        for (int n = 0; n < 2; ++n) { const f32x4 z = acc[ai][0][m][n] * rs + bb[n]; f32x4 lf;
#pragma unroll
                            for (int j = 0; j < 4; ++j) { const float ee = __builtin_amdgcn_exp2f(-1.4426950408889634f * fabsf(z[j]));
                                const float big = 0.6931471805599453f * __builtin_amdgcn_logf(1.0f + ee), sm = ee * (1.0f - ee * (0.5f - ee * (0.3333333333f - 0.25f * ee)));
                                lf[j] = fminf(z[j], 0.f) - (ee < 0.03f ? sm : big); }
                            *(f32x4*)(dst + 8 * fq + 4 * n) = lf; tot[n] += lf; } }
                if (u.pm < 128) { float* blocktot = (float*)(ws + C::o_btot);
#pragma unroll
                    for (int n = 0; n < 2; ++n)
#pragma unroll
                        for (int j = 0; j < 4; ++j) { float s = tot[n][j]; s += __shfl_xor(s, 1); s += __shfl_xor(s, 2); s += __shfl_xor(s, 4); s += __shfl_xor(s, 8);
                            if (fr == 0) __hip_atomic_fetch_add(blocktot + u.pm * 16 + 8 * fq + 4 * n + j, s, __ATOMIC_RELAXED, __HIP_MEMORY_SCOPE_AGENT); }
                }
            }
            return;
        }
        const int cin = (u.pn & 3) * BM + wc * 32 + 8 * fq;
        bf16_t* bdst = (bf16_t*)(ws + ((t == 0) ? C::o_qo : (t == 1) ? C::o_kb : C::o_vb));
        float* fdst = nullptr;
        if (t != 0) { const size_t op = fox ? ((t == 1) ? C::o_fkp : C::o_fvp) : ((t == 1) ? C::o_bkp : C::o_bvp), os = fox ? ((t == 1) ? C::o_fks : C::o_fvs) : ((t == 1) ? C::o_bks : C::o_bvs);
            if (u.pm == 128) fdst = out + os;
            else if (fox) fdst = out + op + (size_t)u.pm * BM * 1024;
            else if ((u.pm & 31) >= 30) fdst = out + op + (size_t)((u.pm >> 5) * 512 + ((u.pm & 31) - 30) * BM) * 1024; }
        const float sc = (t == 0) ? qscale : 1.0f;
        float ssq[2][4];
#pragma unroll
        for (int ai = 0; ai < 2; ++ai)
#pragma unroll
            for (int m = 0; m < 4; ++m) ssq[ai][m] = rowss[row0 + ai * HALF + m * 16];
        asm volatile("" : "+v"(ssq[0][0]), "+v"(ssq[0][1]), "+v"(ssq[0][2]), "+v"(ssq[0][3]), "+v"(ssq[1][0]), "+v"(ssq[1][1]), "+v"(ssq[1][2]), "+v"(ssq[1][3]));
#pragma unroll
        for (int ai = 0; ai < 2; ++ai)
#pragma unroll
            for (int m = 0; m < 4; ++m) { const int rl = wr * 64 + fr + ai * HALF + m * 16, row = u.pm * BM + rl; const float rs = rstd_of(ssq[ai][m]);
#pragma unroll
                for (int bj = 0; bj < 2; ++bj) { const f32x4 v0 = acc[ai][bj][m][0] * rs, v1 = acc[ai][bj][m][1] * rs;
                    if (fdst) { float* fp = fdst + (size_t)rl * 1024 + cin + bj * HALF; *(f32x4*)fp = v0; *(f32x4*)(fp + 4) = v1; }
                    u32x4 w; w.x = cvt_pk_bf16(v0[0] * sc, v0[1] * sc); w.y = cvt_pk_bf16(v0[2] * sc, v0[3] * sc); w.z = cvt_pk_bf16(v1[0] * sc, v1[1] * sc); w.w = cvt_pk_bf16(v1[2] * sc, v1[3] * sc);
                    *(u32x4*)(bdst + (size_t)row * 1024 + cin + bj * HALF) = w; } }
    }
};


template <class Epi, class Sched, bool ALIGN_EPI = false, bool SP2 = false>
__device__ __forceinline__ void gemm_phase(PG8_LAS unsigned char* lds, const Gemm g, const Sched& S, const Epi& E) {
    int tid_ = threadIdx.x; asm volatile("" : "+v"(tid_)); const int tid = tid_, wid = __builtin_amdgcn_readfirstlane(tid >> 6), lane = tid & 63, wr = wid >> 2, wc = wid & 3, fr = lane & 15, fq = lane >> 4;
    const int K = g.K, nt = K / BK;
    unsigned voffA[2], voffB[2];
#pragma unroll
    for (int i = 0; i < 2; ++i) { int R, C; stage_rc(tid * 16 + i * 8192, R, C); const int Rb = Epi::PERM ? ((R & ~31) + perm32(R & 31)) : R;
        voffA[i] = (unsigned)(R * K + C) * 2u; voffB[i] = (unsigned)(Rb * K + C) * 2u; }
    const size_t kstep = (size_t)(BK * 2);
    const size_t hstep = (size_t)HALF * K * 2;
    const size_t tstep = 2 * hstep;
    const unsigned ldsw = (unsigned)wid * 1024u;
    const int aoff = lds_byte(wr * 64 + fr, fq * 8), boff = lds_byte(wc * 32 + fr, fq * 8);
#define PG8_SA(b, h) (((b) * 2 + (h)) * HTB)
#define PG8_SB(b, h) ((4 + (b) * 2 + (h)) * HTB)
#define PG8_STAGE(bufoff, gbase, voff) do { _Pragma("unroll") for (int _i = 0; _i < 2; ++_i) \
        __builtin_amdgcn_global_load_lds((const unsigned*)((const char*)(gbase) + (voff)[_i]), (PG8_LAS unsigned*)(lds + (bufoff) + ldsw + _i * 8192), 16, 0, 0); } while (0)
#define PG8_LDA(dst, b, h) do { _Pragma("unroll") for (int m = 0; m < 4; ++m) _Pragma("unroll") for (int k = 0; k < 2; ++k) dst[m][k] = *(const PG8_LAS bf16x8*)(lds + PG8_SA(b, h) + aoff + m * 2048 + k * 1024); } while (0)
#define PG8_LDB(dst, b, h) do { _Pragma("unroll") for (int n = 0; n < 2; ++n) _Pragma("unroll") for (int k = 0; k < 2; ++k) dst[n][k] = *(const PG8_LAS bf16x8*)(lds + PG8_SB(b, h) + boff + n * 2048 + k * 1024); } while (0)
#define PG8_MMA(ai, bj, At, Bt) do { __builtin_amdgcn_s_setprio(1); _Pragma("unroll") for (int m = 0; m < 4; ++m) _Pragma("unroll") for (int n = 0; n < 2; ++n) _Pragma("unroll") for (int k = 0; k < 2; ++k) \
        acc[ai][bj][m][n] = __builtin_amdgcn_mfma_f32_16x16x32_bf16(Bt[n][k], At[m][k], acc[ai][bj][m][n], 0, 0, 0); __builtin_amdgcn_s_setprio(0); } while (0)
#define PG8_WAIT_V(n) asm volatile("s_waitcnt vmcnt(" #n ")" ::: "memory")
#define PG8_WAIT_L(n) asm volatile("s_waitcnt lgkmcnt(" #n ")" ::: "memory")
#define PG8_BAR __builtin_amdgcn_s_barrier()
#define PG8_SCHED __builtin_amdgcn_sched_barrier(0)
    Unit cur, nxt; int ui = 0;
    if (!S.next(0, cur)) return;
    f32x4 acc[2][2][4][2];
#pragma unroll
    for (int a = 0; a < 2; ++a)
#pragma unroll
        for (int b = 0; b < 2; ++b)
#pragma unroll
            for (int m = 0; m < 4; ++m)
#pragma unroll
                for (int n = 0; n < 2; ++n) acc[a][b][m][n] = (f32x4){0.f, 0.f, 0.f, 0.f};
    bf16x8 At[4][2], B0[2][2], B1[2][2];
    const char* cA = (const char*)g.A + (size_t)cur.pm * tstep; const char* cB = (const char*)g.Bt + (size_t)cur.pn * tstep;
    S.a_ready(cur);
    if constexpr (SP2) {
        PG8_STAGE(PG8_SB(0, 0), cB, voffB); PG8_STAGE(PG8_SB(0, 1), cB + hstep, voffB); PG8_STAGE(PG8_SA(0, 0), cA, voffA); PG8_STAGE(PG8_SA(0, 1), cA + hstep, voffA);
        if (wr == 1) PG8_BAR;
        PG8_WAIT_V(2); PG8_BAR;
        PG8_STAGE(PG8_SB(1, 0), cB + kstep, voffB); PG8_STAGE(PG8_SA(1, 0), cA + kstep, voffA); PG8_STAGE(PG8_SB(1, 1), cB + hstep + kstep, voffB);
        PG8_WAIT_V(6); PG8_BAR;
    } else {
        PG8_STAGE(PG8_SB(0, 0), cB, voffB); PG8_STAGE(PG8_SA(0, 0), cA, voffA); PG8_STAGE(PG8_SB(0, 1), cB + hstep, voffB); PG8_STAGE(PG8_SA(0, 1), cA + hstep, voffA);
        if (wr == 1) PG8_BAR;
        PG8_WAIT_V(4); PG8_BAR;
        PG8_STAGE(PG8_SB(1, 0), cB + kstep, voffB); PG8_STAGE(PG8_SA(1, 0), cA + kstep, voffA); PG8_STAGE(PG8_SB(1, 1), cB + hstep + kstep, voffB);
        PG8_WAIT_V(6); PG8_BAR;
    }
    for (;;) {
        const bool has_next = S.next(ui + 1, nxt);
        const char* nA = has_next ? (const char*)g.A + (size_t)nxt.pm * tstep : cA; const char* nB = has_next ? (const char*)g.Bt + (size_t)nxt.pn * tstep : cB;
        for (int t = 0; t < nt; t += 2) {
            const bool last = (t == nt - 2);
            const char* a1 = cA + (size_t)(t + 1) * kstep;
            const char* a2 = last ? nA : cA + (size_t)(t + 2) * kstep; const char* b2 = last ? nB : cB + (size_t)(t + 2) * kstep;
            const char* a3 = a2 + kstep; const char* b3 = b2 + kstep;
            if (last && has_next) S.a_ready(nxt);
            if constexpr (SP2) {
            PG8_LDB(B0, 0, 0); PG8_LDB(B1, 0, 1); PG8_SCHED; PG8_LDA(At, 0, 0); PG8_STAGE(PG8_SA(1, 1), a1 + hstep, voffA);
            PG8_WAIT_V(8); PG8_WAIT_L(0); PG8_BAR; PG8_MMA(0, 0, At, B0); PG8_MMA(0, 1, At, B1); PG8_BAR; PG8_SCHED;
            PG8_LDA(At, 0, 1); PG8_STAGE(PG8_SB(0, 0), b2, voffB); PG8_STAGE(PG8_SB(0, 1), b2 + hstep, voffB); PG8_STAGE(PG8_SA(0, 0), a2, voffA);
            PG8_WAIT_V(8); PG8_WAIT_L(0); PG8_BAR; PG8_MMA(1, 0, At, B0); PG8_MMA(1, 1, At, B1); PG8_BAR; PG8_SCHED;
            PG8_LDB(B0, 1, 0); PG8_LDB(B1, 1, 1); PG8_SCHED; PG8_LDA(At, 1, 0); PG8_STAGE(PG8_SA(0, 1), a2 + hstep, voffA);
            PG8_WAIT_V(8); PG8_WAIT_L(0); PG8_BAR; PG8_MMA(0, 0, At, B0); PG8_MMA(0, 1, At, B1); PG8_BAR; PG8_SCHED;
            PG8_LDA(At, 1, 1); PG8_STAGE(PG8_SB(1, 0), b3, voffB); PG8_STAGE(PG8_SB(1, 1), b3 + hstep, voffB); PG8_STAGE(PG8_SA(1, 0), a3, voffA);
            PG8_WAIT_V(8); PG8_WAIT_L(0); PG8_BAR; PG8_MMA(1, 0, At, B0); PG8_MMA(1, 1, At, B1); PG8_BAR; PG8_SCHED;
            } else {
            PG8_LDB(B0, 0, 0); PG8_SCHED; PG8_LDA(At, 0, 0); PG8_STAGE(PG8_SA(1, 1), a1 + hstep, voffA);
            PG8_WAIT_L(8); PG8_BAR; PG8_WAIT_L(0); PG8_MMA(0, 0, At, B0); PG8_BAR; PG8_SCHED;
            PG8_LDB(B1, 0, 1); PG8_STAGE(PG8_SB(0, 0), b2, voffB);
            PG8_BAR; PG8_WAIT_L(0); PG8_MMA(0, 1, At, B1); PG8_BAR;
            PG8_LDA(At, 0, 1); PG8_STAGE(PG8_SA(0, 0), a2, voffA);
            PG8_BAR; PG8_WAIT_L(0); PG8_MMA(1, 0, At, B0); PG8_BAR; PG8_SCHED;
            PG8_STAGE(PG8_SB(0, 1), b2 + hstep, voffB);
            PG8_WAIT_V(6); PG8_BAR; PG8_MMA(1, 1, At, B1); PG8_BAR;
            PG8_LDB(B0, 1, 0); PG8_SCHED; PG8_LDA(At, 1, 0); PG8_STAGE(PG8_SA(0, 1), a2 + hstep, voffA);
            PG8_WAIT_L(8); PG8_BAR; PG8_WAIT_L(0); PG8_MMA(0, 0, At, B0); PG8_BAR; PG8_SCHED;
            PG8_LDB(B1, 1, 1); PG8_STAGE(PG8_SB(1, 0), b3, voffB);
            PG8_BAR; PG8_WAIT_L(0); PG8_MMA(0, 1, At, B1); PG8_BAR;
            PG8_LDA(At, 1, 1); PG8_STAGE(PG8_SA(1, 0), a3, voffA);
            PG8_BAR; PG8_WAIT_L(0); PG8_MMA(1, 0, At, B0); PG8_BAR; PG8_SCHED;
            PG8_STAGE(PG8_SB(1, 1), b3 + hstep, voffB);
            PG8_WAIT_V(6); PG8_BAR; PG8_MMA(1, 1, At, B1); PG8_BAR;
            }
        }
        if constexpr (ALIGN_EPI) { if (wr == 0) PG8_BAR; }
        if constexpr (!Epi::AFTER_DRAIN) { E(acc, cur, wr, wc, fr, fq); S.done(cur); }
        if (!has_next) break;
#pragma unroll
        for (int a = 0; a < 2; ++a)
#pragma unroll
            for (int b = 0; b < 2; ++b)
#pragma unroll
                for (int m = 0; m < 4; ++m)
#pragma unroll
                    for (int n = 0; n < 2; ++n) acc[a][b][m][n] = (f32x4){0.f, 0.f, 0.f, 0.f};
        cur = nxt; cA = nA; cB = nB; ++ui;
        if constexpr (ALIGN_EPI) { if (wr == 1) PG8_BAR; }
    }
    PG8_WAIT_V(0);
    if constexpr (!ALIGN_EPI) { if (wr == 0) PG8_BAR; }
    PG8_BAR;
    if constexpr (Epi::AFTER_DRAIN) { E.fused(acc, cur, wr, wc, fr, fq, lds, wid, lane); S.done(cur); }
#undef PG8_SA
#undef PG8_SB
#undef PG8_STAGE
#undef PG8_LDA
#undef PG8_LDB
#undef PG8_MMA
#undef PG8_WAIT_V
#undef PG8_WAIT_L
#undef PG8_BAR
#undef PG8_SCHED
}
}
namespace attn_body {
using bf16=__hip_bfloat16;
using bf16x8=__attribute__((ext_vector_type(8)))short;
using s16x4=__attribute__((ext_vector_type(4)))short;
using f32x16=__attribute__((ext_vector_type(16)))float;
using f32x4=__attribute__((ext_vector_type(4)))float;
using u32x4=__attribute__((ext_vector_type(4)))unsigned;
constexpr int NHEAD=16,SEQ=8192,D=64,DM=NHEAD*D;
constexpr int NW=8,QBLK=32,QB=QBLK*NW,KVBLK=64,NQB=SEQ/QB;
constexpr float L2E=1.4426950408889634f;
__device__ __forceinline__ int crow(int r,int hi){return (r&3)+8*(r>>2)+4*hi;}
#define SBAR() __builtin_amdgcn_sched_barrier(0)
__device__ __forceinline__ void cmask(f32x16&p0,f32x16&p1,int jb,int qrel,int hi){
  const float NEG=-INFINITY; int kb=64*jb+4*hi;
  #pragma unroll
  for(int r=0;r<16;++r){int kv=kb+(r&3)+8*(r>>2); if(kv>qrel)p0[r]=NEG; if(kv+32>qrel)p1[r]=NEG;}
}
constexpr int NSLOT=3, SLOTB=8192;
constexpr int LDS_K=0, LDS_V=NSLOT*SLOTB, LDS_WS=2*NSLOT*SLOTB, LDS_OST=LDS_WS+NW*64*4, LDS_X=LDS_OST+NW*4096;
constexpr int LDS_VOTE=LDS_X+32768; constexpr int LDS_BYTES=LDS_VOTE+64;
constexpr float C2=0.125f*L2E;
__device__ __forceinline__ void glds16(const void*gsrc,unsigned lds_dst){unsigned keep;
  asm volatile("s_mov_b32 %0, m0\n\ts_mov_b32 m0, %2\n\ts_nop 0\n\tglobal_load_lds_dwordx4 %1, off\n\ts_mov_b32 m0, %0":"=&s"(keep):"v"(gsrc),"s"(lds_dst):"memory");}
__device__ __forceinline__ float max3f(float a,float b,float c){float r;asm("v_max3_f32 %0, %1, %2, %3":"=v"(r):"v"(a),"v"(b),"v"(c));return r;}
__device__ __forceinline__ float max2f(float a,float b){float r;asm("v_max_f32_e32 %0, %1, %2":"=v"(r):"v"(a),"v"(b));return r;}
__device__ __forceinline__ float fadd_s(float a,float b){float r;asm("v_add_f32_e32 %0, %1, %2":"=v"(r):"v"(a),"v"(b));return r;}
__device__ __forceinline__ float fsub_s(float a,float b){float r;asm("v_sub_f32_e32 %0, %1, %2":"=v"(r):"v"(a),"v"(b));return r;}
typedef float f32x2_t __attribute__((ext_vector_type(2))); typedef __bf16 bf16x2_t __attribute__((ext_vector_type(2)));
__device__ __forceinline__ unsigned cvtpk_s(float lo,float hi){f32x2_t v={lo,hi};bf16x2_t b=__builtin_convertvector(v,bf16x2_t);return __builtin_bit_cast(unsigned,b);}
#define WAIT_BAR(N) asm volatile("s_waitcnt vmcnt(" #N ") lgkmcnt(0)\n\ts_barrier":::"memory")
#define MF32(a,b,c) __builtin_amdgcn_mfma_f32_32x32x16_bf16(a,b,c,0,0,0)

__device__ __forceinline__ void qkt(f32x16&p0,f32x16&p1,const char*Kslot,const bf16x8*qr,int r32,int hi){
  const char*kb=Kslot+hi*1024+r32*16;
  #pragma unroll
  for(int d0=0;d0<4;++d0){
    const bf16x8 b0=*reinterpret_cast<const bf16x8*>(kb+d0*2048);
    const bf16x8 b1=*reinterpret_cast<const bf16x8*>(kb+d0*2048+512);
    p0=MF32(b0,qr[d0],p0);p1=MF32(b1,qr[d0],p1);}
}
typedef __attribute__((address_space(3))) const char* lds_cptr;
typedef short v4i16_t __attribute__((ext_vector_type(4)));
__device__ __forceinline__ void kload8(bf16x8*kf,lds_cptr kp){
  kf[0]=*(const __attribute__((address_space(3))) bf16x8*)(kp);      kf[1]=*(const __attribute__((address_space(3))) bf16x8*)(kp+512);
  kf[2]=*(const __attribute__((address_space(3))) bf16x8*)(kp+2048); kf[3]=*(const __attribute__((address_space(3))) bf16x8*)(kp+2560);
  kf[4]=*(const __attribute__((address_space(3))) bf16x8*)(kp+4096); kf[5]=*(const __attribute__((address_space(3))) bf16x8*)(kp+4608);
  kf[6]=*(const __attribute__((address_space(3))) bf16x8*)(kp+6144); kf[7]=*(const __attribute__((address_space(3))) bf16x8*)(kp+6656);
}
__device__ __forceinline__ void kload2(bf16x8*kf,lds_cptr kp,int j){ kf[2*j]=*(const __attribute__((address_space(3))) bf16x8*)(kp+j*2048); kf[2*j+1]=*(const __attribute__((address_space(3))) bf16x8*)(kp+j*2048+512); }
__device__ __forceinline__ s16x4 vtr(lds_cptr p){ return __builtin_bit_cast(s16x4,__builtin_amdgcn_ds_read_tr16_b64_v4i16((__attribute__((address_space(3))) v4i16_t*)p)); }
__device__ __forceinline__ float rowmax(const f32x16&p0,const f32x16&p1){
  float a=max3f(p0[0],p0[1],p1[0]),b=max3f(p0[2],p0[3],p1[1]);a=max3f(a,p1[2],p1[3]);
  #pragma unroll
  for(int r=4;r<16;r+=4){a=max3f(a,p0[r],p0[r+1]);b=max3f(b,p0[r+2],p0[r+3]);a=max3f(a,p1[r],p1[r+1]);b=max3f(b,p1[r+2],p1[r+3]);}
  const float m=max2f(a,b);
  auto rr=__builtin_amdgcn_permlane32_swap(__float_as_uint(m),__float_as_uint(m),false,false);
  return max2f(__uint_as_float(rr[0]),__uint_as_float(rr[1]));
}
__device__ __forceinline__ void pv(f32x16*o,int vb,bf16x8 pa0,bf16x8 pa1,bf16x8 pa2,bf16x8 pa3){
  #pragma unroll
  for(int d0=0;d0<2;++d0){s16x4 lo[4],hi[4];
    #pragma unroll
    for(int ks=0;ks<4;++ks){
      asm volatile("ds_read_b64_tr_b16 %0,%1 offset:%c2":"=&v"(lo[ks]):"v"(vb),"i"(d0*4096+ks*1024):"memory");
      asm volatile("ds_read_b64_tr_b16 %0,%1 offset:%c2":"=&v"(hi[ks]):"v"(vb),"i"(d0*4096+ks*1024+512):"memory");}
    asm volatile("s_waitcnt lgkmcnt(0)":::"memory");SBAR();
    #define PK(k) (bf16x8){lo[k][0],lo[k][1],lo[k][2],lo[k][3],hi[k][0],hi[k][1],hi[k][2],hi[k][3]}
    o[d0]=MF32(pa0,PK(0),o[d0]);
    o[d0]=MF32(pa1,PK(1),o[d0]);
    o[d0]=MF32(pa2,PK(2),o[d0]);
    o[d0]=MF32(pa3,PK(3),o[d0]);
    #undef PK
  }
}
__device__ __forceinline__ void split3(float v,unsigned&h,unsigned&m,unsigned&l){
  const unsigned u=__float_as_uint(v); h=u&0xffff0000u; const float r1=v-__uint_as_float(h); m=__float_as_uint(r1)&0xffff0000u; const float r2=r1-__uint_as_float(m); l=__float_as_uint(r2)&0xffff0000u; }
__device__ __forceinline__ bf16x8 kfeat(float v,int hi){ unsigned h,m,l; split3(v,h,m,l); u32x4 w; w.x=(h>>16)|m; w.y=(l>>16)|0x3f800000u; w.z=0x3f803f80u; w.w=0u; if(hi){w.x=0u;w.y=0u;w.z=0u;} return __builtin_bit_cast(bf16x8,w); }
__device__ __forceinline__ bf16x8 qfeat(float v,int hi){ unsigned h,m,l; split3(v,h,m,l); u32x4 w; w.x=0x3f803f80u; w.y=0x00003f80u|h; w.z=(m>>16)|l; w.w=0u; if(hi){w.x=0u;w.y=0u;w.z=0u;} return __builtin_bit_cast(bf16x8,w); }

#ifndef ATTN_STORE16
#define ATTN_STORE16(p,v) (*(u32x4*)(p)=(v))
#endif
template<int MODE,int THRL> __device__ __forceinline__ void attn_unit(int b,int h,int qb,const bf16*Q,const bf16*__restrict__ K,const bf16*__restrict__ V,bf16*O,char*shm,const float*__restrict__ cs2,const float*__restrict__ relb,float kmx){
  int tid_=threadIdx.x; asm volatile("":"+v"(tid_)); const int tid=tid_,lane=tid&63,r32=lane&31,hi=lane>>5; const int wid=__builtin_amdgcn_readfirstlane(tid>>6);
  const long rowbase=(long)b*SEQ; const int q0=qb*QB;
  const int t_lo=(MODE==1)?((4*qb-8)>0?(4*qb-8):0):0;
  const int NT=(q0+QB)/KVBLK-t_lo;
  const bf16*Qw=Q+(rowbase+q0+wid*QBLK)*DM+h*D;
  const bf16*Kh=K+(rowbase+(long)t_lo*KVBLK)*DM+h*D,*Vh=V+(rowbase+(long)t_lo*KVBLK)*DM+h*D;
  const unsigned lds0=(unsigned)(uintptr_t)shm;
  float*wsf=(float*)(shm+LDS_WS)+wid*64;
  const bf16*ksrc=Kh+(long)lane*DM+wid*8;
  const bf16*vsrc=Vh+(long)(16*(wid&3)+(lane>>2))*DM+(wid>>2)*32+(lane&3)*8;
  const unsigned kdst=lds0+LDS_K+wid*1024, vdst=lds0+LDS_V+wid*1024;
  #define TM(t) ((MODE==0)?(NT-1-(t)):(t))
  #define DMA_K(t,slot) glds16(ksrc+(long)TM(t)*KVBLK*DM,(unsigned)__builtin_amdgcn_readfirstlane(kdst+(slot)))
  #define DMA_V(t,slot) glds16(vsrc+(long)TM(t)*KVBLK*DM,(unsigned)__builtin_amdgcn_readfirstlane(vdst+(slot)))
  const int vb0=(int)(lds0+LDS_V)+((lane>>4)&1)*32+(lane&3)*8+(4*hi+((lane&15)>>2))*64;
  const char*Kbase=shm+LDS_K; bf16x8 kf[8];
  const lds_cptr shm3=(lds_cptr)shm; const lds_cptr kp0=shm3+LDS_K+hi*1024+r32*16; const lds_cptr vp0=shm3+LDS_V+((lane>>4)&1)*32+(lane&3)*8+(4*hi+((lane&15)>>2))*64;
  DMA_K(0,0);DMA_V(0,0);DMA_K(1,SLOTB);
  bf16x8 qr[4];
  #pragma unroll
  for(int d0=0;d0<4;++d0)qr[d0]=*reinterpret_cast<const bf16x8*>(&Qw[(long)r32*DM+d0*16+hi*8]);
  float ub=0.f;
  if constexpr(MODE==0){ float s2=0.f;
    #pragma unroll
    for(int d0=0;d0<4;++d0){
      #pragma unroll
      for(int j=0;j<8;++j){ const float f=__uint_as_float(((unsigned)(unsigned short)qr[d0][j])<<16); s2+=f*f; } }
    { auto rr=__builtin_amdgcn_permlane32_swap(__float_as_uint(s2),__float_as_uint(s2),false,false); s2=__uint_as_float(rr[0])+__uint_as_float(rr[1]); }
    ub=sqrtf(s2)*kmx; }
  volatile __attribute__((address_space(3))) unsigned*votes=(volatile __attribute__((address_space(3))) unsigned*)(shm3+LDS_VOTE);
  if constexpr(MODE==0){ const int nk=NT*KVBLK; for(int i=tid*4;i<nk;i+=NW*64*4) *(__attribute__((address_space(3))) f32x4*)(shm3+LDS_X+i*4)=*(const f32x4*)(cs2+i); }
  else { if(relb){ for(int i=tid;i<2560;i+=NW*64){ const int s=i/640,j=i-s*640; int idx=j+s; idx=idx>639?639:idx; int dist=575-idx; dist=dist>256?256:dist; dist=dist<-256?-256:dist;
           *(__attribute__((address_space(3))) float*)(shm3+LDS_X+s*2576+j*4)=L2E*relb[(dist+256)*16]; } } }
  float mhat=0.f,l_reg=0.f;f32x16 o[2];o[0]=f32x16{};o[1]=f32x16{};
  const f32x16 z16=f32x16{};
  bf16x8 qx=qfeat(0.f,hi); float cn0=0.f,cn1=0.f;
  const int qrel=wid*QBLK+r32;
  const int cw=wid>>1;
  const lds_cptr csl=shm3+LDS_X+r32*4;
  const int bsh=(3-r32)&3;
  const lds_cptr btab=shm3+LDS_X+bsh*2576+4*(64*t_lo+4*hi-(q0+qrel)+575-bsh);
  #define TVALID(t) (((t)<=NT-4+cw)&&((t)+12>=NT+cw))
  #define BUILDKX(tt) do{ if constexpr(MODE==0){ const float c0_=*(const __attribute__((address_space(3))) float*)(csl+TM(tt)*256), c1_=*(const __attribute__((address_space(3))) float*)(csl+TM(tt)*256+128); cn0=c0_; cn1=c1_; } }while(0)
  #define CINIT(C0,C1,t,val_) do{ if constexpr(MODE==0){ const bf16x8 kx0_=kfeat(-cn0,hi), kx1_=kfeat(-cn1,hi); C0=MF32(kx0_,qx,z16); C1=MF32(kx1_,qx,z16); } else { if(val_){ const lds_cptr bp_=btab+(t)*256; \
      _Pragma("unroll") for(int g_=0;g_<4;++g_){ const f32x4 a_=*(const __attribute__((address_space(3))) f32x4*)(bp_+g_*32), c_=*(const __attribute__((address_space(3))) f32x4*)(bp_+g_*32+128); \
        C0[4*g_]=a_[0]-mhat;C0[4*g_+1]=a_[1]-mhat;C0[4*g_+2]=a_[2]-mhat;C0[4*g_+3]=a_[3]-mhat; C1[4*g_]=c_[0]-mhat;C1[4*g_+1]=c_[1]-mhat;C1[4*g_+2]=c_[2]-mhat;C1[4*g_+3]=c_[3]-mhat; } } \
      else { C0=z16; C1=z16; } } }while(0)
  #define CMASK(P0,P1,t,val_,MK) do{ if constexpr(MODE==0){ int jb_=TM(t)-(NT-4); if(jb_>=0)cmask(P0,P1,jb_,qrel,hi); } else { if(!(val_)){ _Pragma("unroll") for(int r=0;r<16;++r){P0[r]=-INFINITY;P1[r]=-INFINITY;} } } }while(0)
  #define SETQX() do{ if constexpr(MODE==0){ qx=qfeat(-mhat,hi); } }while(0)
  bool resc=false;
  #define START(P0,P1) do{ const float rm=rowmax(P0,P1); resc=false; \
    { const float dl=(rm>-1e30f)?rm:0.f; mhat=fadd_s(mhat,dl); \
      _Pragma("unroll") for(int r=0;r<16;++r){P0[r]=fsub_s(P0[r],dl);P1[r]=fsub_s(P1[r],dl);} \
      SETQX(); } \
    _Pragma("unroll") for(int r=0;r<16;++r)P0[r]=__builtin_amdgcn_exp2f(P0[r]); }while(0)
  #define RESC() do{ if(resc){ asm volatile("s_waitcnt lgkmcnt(0)":::"memory"); \
      _Pragma("unroll") for(int d_=0;d_<2;++d_) _Pragma("unroll") for(int r=0;r<16;++r)o[d_][r]*=wsf[crow(r,hi)]; } }while(0)
  f32x16 pA0,pA1,pB0,pB1;
  int sl_prev=0,sl_cur=0,sl_next=SLOTB;
  #define ROT() do{sl_prev=sl_cur;sl_cur=sl_next;sl_next=(sl_next==(NSLOT-1)*SLOTB)?0:sl_next+SLOTB;}while(0)
  DMA_K(2,2*SLOTB);
  WAIT_BAR(3);
  BUILDKX(0);
  { const bool v0_=TVALID(0); CINIT(pA0,pA1,0,v0_);
    qkt(pA0,pA1,Kbase,qr,r32,hi);asm volatile("s_nop 15\n\ts_nop 7":"+v"(pA0),"+v"(pA1));CMASK(pA0,pA1,0,v0_,true); }
  START(pA0,pA1);
  _Pragma("unroll") for(int r=0;r<16;++r)pA1[r]=__builtin_amdgcn_exp2f(pA1[r]);
  WAIT_BAR(0);
  DMA_K(3,0);DMA_V(1,SLOTB);
  ROT();
  kload8(kf,kp0+sl_cur);
  BUILDKX(1);
  WAIT_BAR(2);
  s16x4 vlo[8],vhi[8]; u32x4 pw0,pw1,pw2,pw3;
  #define PKW(P,B) cvtpk_s(P[B],P[B+1])
  #define PAF(k) __builtin_bit_cast(bf16x8,pw##k)
  #define VFR(i) (bf16x8){vlo[i][0],vlo[i][1],vlo[i][2],vlo[i][3],vhi[i][0],vhi[i][1],vhi[i][2],vhi[i][3]}
  #define PIN(x) asm volatile("":"+v"(x))
  #define MX3(a,b,c) __builtin_fmaxf(__builtin_fmaxf((a),(b)),(c))
  #define GAPA(MF,A0,A1,A2,A3,W0,W1,PW) do{ MF; sacc+=A0; sacc+=A1; sacc+=A2; sacc+=A3; PIN(sacc); W0; W1; PIN(PW); SBAR(); }while(0)
  #define EX(v) __builtin_amdgcn_exp2f(v)
  #define GAPB(MF,X,B) do{ MF; X[B]=EX(X[B]); X[B+1]=EX(X[B+1]); X[B+2]=EX(X[B+2]); X[B+3]=EX(X[B+3]); PIN(X); SBAR(); }while(0)
  #define VRD(i) do{ vlo[i]=vtr(vp_+(((i)>>2)*4096+((i)&3)*1024)); vhi[i]=vtr(vp_+(((i)>>2)*4096+((i)&3)*1024+512)); }while(0)
  #define KRD(G,j) do{ if(G){ kload2(kf,kp0+sl_next,j); SBAR(); } }while(0)
  #define STEP(C0,C1,P0,P1,t,GK,GV,GL,MK) do{ SBAR(); \
    const lds_cptr vp_=vp0+sl_prev; const bool val_=TVALID(t); \
    CINIT(C0,C1,t,val_); SBAR(); \
    VRD(0); SBAR(); float sacc=(P0[0]+P0[1]); \
    GAPA(C0=MF32(kf[0],qr[0],C0), P0[2],P0[3],P0[4],P0[5],     pw0[0]=PKW(P0,0), pw0[1]=PKW(P0,2), pw0); \
    VRD(4); SBAR(); GAPA(C1=MF32(kf[1],qr[0],C1), P0[6],P0[7],P0[8],P0[9],     pw0[2]=PKW(P0,4), pw0[3]=PKW(P0,6), pw0); \
    VRD(1); SBAR(); GAPA(C0=MF32(kf[2],qr[1],C0),   P0[10],P0[11],P0[12],P0[13], pw1[0]=PKW(P0,8), pw1[1]=PKW(P0,10), pw1); \
    VRD(5); SBAR(); GAPA(C1=MF32(kf[3],qr[1],C1),   P0[14],P0[15],P1[0],P1[1],   pw1[2]=PKW(P0,12),pw1[3]=PKW(P0,14), pw1); \
    VRD(2); SBAR(); GAPA(C0=MF32(kf[4],qr[2],C0),   P1[2],P1[3],P1[4],P1[5],     pw2[0]=PKW(P1,0), pw2[1]=PKW(P1,2), pw2); \
    VRD(6); SBAR(); GAPA(C1=MF32(kf[5],qr[2],C1),   P1[6],P1[7],P1[8],P1[9],     pw2[2]=PKW(P1,4), pw2[3]=PKW(P1,6), pw2); \
    VRD(3); SBAR(); GAPA(C0=MF32(kf[6],qr[3],C0),   P1[10],P1[11],P1[12],P1[13], pw3[0]=PKW(P1,8), pw3[1]=PKW(P1,10), pw3); \
    VRD(7); SBAR(); GAPA(C1=MF32(kf[7],qr[3],C1),   P1[14],P1[15],0.f,0.f,       pw3[2]=PKW(P1,12),pw3[3]=PKW(P1,14), pw3); \
    l_reg+=sacc; \
    if(GK){DMA_K((t)+3,sl_cur);} if(GV){DMA_V((t)+1,sl_next);} \
    CMASK(C0,C1,t,val_,MK); \
    { float a=MX3(C0[0],C0[1],C1[0]),b=MX3(C0[2],C0[3],C1[1]); a=MX3(a,C1[2],C1[3]); \
      _Pragma("unroll") for(int r=4;r<16;r+=4){a=MX3(a,C0[r],C0[r+1]);b=MX3(b,C0[r+2],C0[r+3]);a=MX3(a,C1[r],C1[r+1]);b=MX3(b,C1[r+2],C1[r+3]);} \
      float rm=__builtin_fmaxf(a,b); { auto rr=__builtin_amdgcn_permlane32_swap(__float_as_uint(rm),__float_as_uint(rm),false,false); rm=__builtin_fmaxf(__uint_as_float(rr[0]),__uint_as_float(rr[1])); } \
      resc=false; \
      if(__builtin_expect(__any(rm>(float)THRL),0)){ const float dl=__builtin_fmaxf(rm,0.f); mhat+=dl; \
        _Pragma("unroll") for(int r=0;r<16;++r){C0[r]-=dl;C1[r]-=dl;} \
        SETQX(); \
        const float f=__builtin_amdgcn_exp2f(-dl); l_reg*=f; if(hi==0)wsf[r32]=f; resc=true; } } \
    SBAR(); \
    GAPB(o[0]=MF32(PAF(0),VFR(0),o[0]), C0,0); \
    GAPB(o[1]=MF32(PAF(0),VFR(4),o[1]), C0,4); \
    KRD(GL,0); GAPB(o[0]=MF32(PAF(1),VFR(1),o[0]), C0,8); \
    KRD(GL,1); GAPB(o[1]=MF32(PAF(1),VFR(5),o[1]), C0,12); \
    KRD(GL,2); GAPB(o[0]=MF32(PAF(2),VFR(2),o[0]), C1,0); \
    KRD(GL,3); GAPB(o[1]=MF32(PAF(2),VFR(6),o[1]), C1,4); \
    GAPB(o[0]=MF32(PAF(3),VFR(3),o[0]), C1,8); \
    GAPB(o[1]=MF32(PAF(3),VFR(7),o[1]), C1,12); \
    if(GL){ BUILDKX((t)+1); } \
    }while(0)
  int t=1; bool early=false;
  for(;t+5<NT;t+=2){
    STEP(pB0,pB1,pA0,pA1,t,true,true,true,false);     WAIT_BAR(2); RESC(); ROT();
    STEP(pA0,pA1,pB0,pB1,t+1,true,true,true,false);
    if constexpr(MODE==0){ if(t>=3){ const float Bn=-*(const __attribute__((address_space(3))) float*)(shm3+LDS_X+(64*(NT-3-t)+63)*4); const bool c_=(ub+Bn-mhat)<-152.f; const bool a_=__all(c_); if(lane==0)votes[wid]=a_?1u:0u; } }
    WAIT_BAR(2); RESC(); ROT();
    if constexpr(MODE==0){ if(t>=3){ const unsigned v_=votes[0]&votes[1]&votes[2]&votes[3]&votes[4]&votes[5]&votes[6]&votes[7]; if(__builtin_amdgcn_readfirstlane(v_)!=0u){ early=true; break; } } }
  }
  if(!early){
  #define ENDW(tt) do{ if((tt)+3<NT){WAIT_BAR(2);} else if((tt)+2<NT){WAIT_BAR(1);} else {WAIT_BAR(0);} }while(0)
  for(;t+1<NT;t+=2){
    STEP(pB0,pB1,pA0,pA1,t,(t+3<NT),(t+1<NT),(t+1<NT),true);       ENDW(t);   RESC(); ROT();
    STEP(pA0,pA1,pB0,pB1,t+1,(t+4<NT),(t+2<NT),(t+2<NT),true);     ENDW(t+1); RESC(); ROT();
  }
  STEP(pB0,pB1,pA0,pA1,NT-1,false,false,false,true); RESC();
  } else { pB0=pA0; pB1=pA1; }
  const int sl_d=early?sl_prev:sl_cur;
  { float sacc=pB0[0]+pB0[1]; _Pragma("unroll") for(int r=2;r<16;++r)sacc+=pB0[r]; _Pragma("unroll") for(int r=0;r<16;++r)sacc+=pB1[r]; l_reg+=sacc;
    pw0=(u32x4){PKW(pB0,0),PKW(pB0,2),PKW(pB0,4),PKW(pB0,6)};pw1=(u32x4){PKW(pB0,8),PKW(pB0,10),PKW(pB0,12),PKW(pB0,14)};pw2=(u32x4){PKW(pB1,0),PKW(pB1,2),PKW(pB1,4),PKW(pB1,6)};pw3=(u32x4){PKW(pB1,8),PKW(pB1,10),PKW(pB1,12),PKW(pB1,14)};
    SBAR(); pv(o,vb0+sl_d,PAF(0),PAF(1),PAF(2),PAF(3)); }
  if(early) asm volatile("s_waitcnt vmcnt(0)":::"memory");
  #undef PKW
  #undef PAF
  #undef VFR
  #undef PIN
  #undef MX3
  #undef GAPA
  #undef GAPB
  #undef EX
  #undef VRD
  #undef KRD
  #undef STEP
  #undef ENDW
  {auto rr=__builtin_amdgcn_permlane32_swap(__float_as_uint(l_reg),__float_as_uint(l_reg),false,false);l_reg=__uint_as_float(rr[0])+__uint_as_float(rr[1]);}
  if(hi==0)wsf[32+r32]=l_reg;asm volatile("s_waitcnt lgkmcnt(0)":::"memory");
  float rli[16];
  #pragma unroll
  for(int r=0;r<16;++r)rli[r]=__builtin_amdgcn_rcpf(wsf[32+crow(r,hi)]);
  bf16*Ow=O+(rowbase+q0+wid*QBLK)*DM+h*D;
  { bf16*stg=(bf16*)(shm+LDS_OST)+wid*2048;
    #pragma unroll
    for(int r=0;r<16;++r){const int orow=crow(r,hi);
      #pragma unroll
      for(int d0=0;d0<2;++d0)stg[orow*64+d0*32+r32]=__float2bfloat16(o[d0][r]*rli[r]);}
    asm volatile("s_waitcnt lgkmcnt(0)":::"memory");
    #pragma unroll
    for(int i=0;i<4;++i){const int row=i*8+(lane>>3),ch=lane&7; const u32x4 v=*(const u32x4*)(stg+row*64+ch*8); ATTN_STORE16(Ow+(long)row*DM+ch*8,v);} }
  asm volatile("s_waitcnt lgkmcnt(0)\n\ts_barrier":::"memory");
  #undef DMA_K
  #undef TM
  #undef DMA_V
  #undef CMASK
  #undef CINIT
  #undef BUILDKX
  #undef SETQX
  #undef TVALID
  #undef START
  #undef RESC
  #undef ROT
}
constexpr int ATTN_LDS_BYTES=LDS_BYTES;
#undef SBAR
#undef WAIT_BAR
#undef MF32
}
constexpr int NWAVES = 8;
#ifndef MK_N_LAUNCHES
#define MK_N_LAUNCHES 1
#endif
constexpr int N_PHASES = 18;
constexpr int DMODEL = 1024, NHEADS = 16, HDIM = 64, DFF = 4096, SEQL = 8192, NBATCH = 4, MP = NBATCH * SEQL, MS = 256, MTOT = MP + MS;
constexpr int PAST = 1024, WINC = 512, NREL = 513;
constexpr float L2E = 1.4426950408889634f;
constexpr size_t O_Y = 0, O_BKP = (size_t)MTOT * 1024, O_BVP = O_BKP + 4 * 512 * 1024, O_BKS = O_BVP + 4 * 512 * 1024, O_BVS = O_BKS + 262144,
                 O_FKP = O_BVS + 262144, O_FVP = O_FKP + (size_t)MP * 1024, O_FLP = O_FVP + (size_t)MP * 1024, O_FKS = O_FLP + (size_t)MP * 16, O_FVS = O_FKS + 262144, O_FLS = O_FVS + 262144, O_END = O_FLS + 4096;
constexpr size_t MiB = 1u << 20;
constexpr size_t WS_CTL = 0, CTL_ZERO_BYTES = 1 * MiB;
constexpr size_t WS_ROWSS = 1 * MiB;
constexpr size_t WS_BTOT = WS_ROWSS + 7 * (size_t)MTOT * 4;
constexpr size_t WS_CS2 = 2 * MiB;
constexpr size_t WS_W = 4 * MiB, W_LAYER = 57 * MiB;
constexpr size_t W_GUA = 0, W_DA = 16 * MiB, W_QKV = 24 * MiB, W_O = 31 * MiB, W_GUB = 33 * MiB, W_DB = 49 * MiB;
constexpr size_t WS_XG = 118 * MiB;
constexpr size_t WS_ACT = 183 * MiB;
constexpr size_t WS_QO = 183 * MiB, WS_KB = 248 * MiB, WS_VB = 313 * MiB;
constexpr size_t WS_OB = 441 * MiB;
constexpr size_t WS_END = 506 * MiB;
static_assert(WS_BTOT + 128 * 16 * 4 <= WS_CS2 && WS_ACT + (size_t)MTOT * 4096 * 2 <= WS_OB && WS_OB + (size_t)MTOT * 2048 <= WS_END && WS_XG + (size_t)MTOT * 2048 <= WS_ACT && WS_W + 2 * W_LAYER <= WS_XG, "ws map");
constexpr int CW_BAR = 4096, CW_QUEUE = 16384;
constexpr int RING_OFF = 0, RING_BYTES = 131072;
constexpr int LDSCTL_OFF = RING_BYTES, MISC_OFF = LDSCTL_OFF + 320;
constexpr int LDS_BYTES = 147456;
static_assert(attn_body::ATTN_LDS_BYTES + 64 <= RING_BYTES, "attention LDS");

#define GAS __attribute__((address_space(1)))
#define LAS __attribute__((address_space(3)))
typedef unsigned short bf16;
typedef unsigned v4u __attribute__((ext_vector_type(4)));
typedef float f32x4 __attribute__((ext_vector_type(4)));
typedef short bf16x8 __attribute__((ext_vector_type(8)));
typedef GAS unsigned gu32;
#define RLX_AGENT __ATOMIC_RELAXED, __HIP_MEMORY_SCOPE_AGENT
#define LDS_WAIT() asm volatile("s_waitcnt lgkmcnt(0)" ::: "memory")
#define VM_WAIT() asm volatile("s_waitcnt vmcnt(0)" ::: "memory")
__device__ __forceinline__ unsigned f2bf(float f) { unsigned u = __builtin_bit_cast(unsigned, f); return (u + 0x7fffu + ((u >> 16) & 1u)) >> 16; }
__device__ __forceinline__ unsigned pk2(float lo, float hi) { return f2bf(lo) | (f2bf(hi) << 16); }
__device__ __forceinline__ float bf2f(unsigned short b) { return __builtin_bit_cast(float, (unsigned)b << 16); }
struct QkvOff { static constexpr size_t o_qo = WS_QO, o_kb = WS_KB, o_vb = WS_VB, o_rowss0 = WS_ROWSS, o_btot = WS_BTOT, o_bkp = O_BKP, o_bvp = O_BVP, o_bks = O_BKS, o_bvs = O_BVS,
    o_fkp = O_FKP, o_fvp = O_FVP, o_fks = O_FKS, o_fvs = O_FVS, o_flp = O_FLP, o_fls = O_FLS; static constexpr int mtot = MTOT; };
#define XB_TMO      128
#define XB_XCNT(j)  (256  + 64 * (j))
#define XB_XSUB(j)  (1280 + 64 * (j))
#define XB_XGEN(j)  (2304 + 64 * (j))
#define XB_TOP      3328
#define XB_TOPGEN   3392
#define XCD_BAR_WORDS 3456
#define XB_SPIN_CAP (1u << 18)

__device__ __forceinline__ unsigned xb_ld(unsigned* p)              { return __hip_atomic_load(p, __ATOMIC_RELAXED, __HIP_MEMORY_SCOPE_AGENT); }
__device__ __forceinline__ unsigned xb_add(unsigned* p, unsigned v) { return __hip_atomic_fetch_add(p, v, __ATOMIC_RELAXED, __HIP_MEMORY_SCOPE_AGENT); }
__device__ __forceinline__ unsigned xb_xcc_id() { return (unsigned)__builtin_amdgcn_s_getreg((3 << 11) | 20) & 0xFu; }
#define XB_SPIN(cond, bar) do { unsigned _sp = 0; while (cond) { __builtin_amdgcn_s_sleep(1); \
    if ((++_sp & 255u) == 0u) { if (xb_ld(&(bar)[XB_TMO])) break; if (_sp > XB_SPIN_CAP) { atomicAdd(&(bar)[XB_TMO], 1u); break; } } } } while (0)

struct XcdBarrier {
    unsigned* bar; unsigned x;
    volatile LAS unsigned* st;
};

__device__ __forceinline__ XcdBarrier xcd_barrier_post(unsigned* bar, volatile LAS unsigned* st) {
    XcdBarrier b; b.bar = bar; b.x = xb_xcc_id(); b.st = st;
    if (threadIdx.x == 0) (void)xb_add(&bar[XB_XCNT(b.x)], 1u);
    return b;
}
__device__ __forceinline__ void xcd_barrier_complete(unsigned* bar, unsigned x, unsigned& nloc, unsigned& nx) {
    const unsigned G = gridDim.x * gridDim.y * gridDim.z;
    unsigned sum, cnt, mine, sp = 0u;
    for (;;) {
        sum = 0u; cnt = 0u; mine = 0u;
#pragma unroll
        for (unsigned j = 0; j < 16; ++j) { const unsigned c = xb_ld(&bar[XB_XCNT(j)]); sum += c; cnt += (c > 0u) ? 1u : 0u; mine = (j == x) ? c : mine; }
        if (sum == G) break;
        __builtin_amdgcn_s_sleep(1);
        if ((++sp & 255u) == 0u) { if (xb_ld(&bar[XB_TMO])) break; if (sp > XB_SPIN_CAP) { atomicAdd(&bar[XB_TMO], 1u); break; } }
    }
    nloc = mine > 0u ? mine : 1u; nx = cnt > 0u ? cnt : 1u;
}

__device__ __forceinline__ void xcd_barrier(const XcdBarrier& b) {
    asm volatile("s_waitcnt vmcnt(0)" ::: "memory");
    __syncthreads();
    if (threadIdx.x == 0) {
        unsigned* bar = b.bar;
        __builtin_amdgcn_s_waitcnt(0);
        unsigned nloc = b.st[0], nx = b.st[1];
        if (nloc == 0u) { xcd_barrier_complete(bar, b.x, nloc, nx); b.st[0] = nloc; b.st[1] = nx; }
        const unsigned old = xb_add(&bar[XB_XSUB(b.x)], 1u);
        const unsigned gen = old / nloc;
        if (old + 1u == (gen + 1u) * nloc) {
            __builtin_amdgcn_fence(__ATOMIC_RELEASE, "agent");
            asm volatile("s_waitcnt vmcnt(0)" ::: "memory");
            const unsigned og = xb_add(&bar[XB_TOP], 1u);
            const unsigned tg = og / nx;
            if (og + 1u == (tg + 1u) * nx) xb_add(&bar[XB_TOPGEN], 1u);
            else XB_SPIN(xb_ld(&bar[XB_TOPGEN]) == tg, bar);
            __builtin_amdgcn_fence(__ATOMIC_ACQUIRE, "agent");
            xb_add(&bar[XB_XGEN(b.x)], 1u);
            asm volatile("s_waitcnt vmcnt(0)" ::: "memory");
        } else {
            XB_SPIN(xb_ld(&bar[XB_XGEN(b.x)]) == gen, bar);
            __builtin_amdgcn_fence(__ATOMIC_ACQUIRE, "agent");
            asm volatile("s_waitcnt vmcnt(0)" ::: "memory");
        }
    }
    __syncthreads();
}

__device__ __forceinline__ float wave_sum(float v) {
#pragma unroll
    for (int o = 1; o < 64; o <<= 1) v += __shfl_xor(v, o);
    return v;
}
struct TrItem { const float* W; bf16* WT; const float* g; int K, N, mode, item; };
__device__ __forceinline__ void tr_load(const TrItem& t, int lane, f32x4 (&v)[8]) {
    const int nblk = t.N / 32, kb = t.item / nblk, nb = t.item % nblk, k0 = 64 * kb, n0 = 32 * nb;
#pragma unroll
    for (int i = 0; i < 8; ++i) { const int kk = 8 * i + (lane >> 3), n4 = (lane & 7) * 4; v[i] = *(const f32x4*)(t.W + (size_t)(k0 + kk) * t.N + n0 + n4); }
}
__device__ __forceinline__ void tr_finish(const TrItem& t, int lane, const f32x4 (&v)[8], LAS float* scr) {
    const int nblk = t.N / 32, kb = t.item / nblk, nb = t.item % nblk, k0 = 64 * kb, n0 = 32 * nb;
    const int drow = (t.mode == 0) ? n0 : ((n0 >> 7) * 256 + (n0 & 127) + (t.mode == 2 ? 128 : 0));
#pragma unroll
    for (int i = 0; i < 8; ++i) { const int kk = 8 * i + (lane >> 3), n4 = (lane & 7) * 4; const float gk = t.g ? t.g[k0 + kk] : 1.0f;
        scr[kk * 33 + n4] = v[i].x * gk; scr[kk * 33 + n4 + 1] = v[i].y * gk; scr[kk * 33 + n4 + 2] = v[i].z * gk; scr[kk * 33 + n4 + 3] = v[i].w * gk; }
    LDS_WAIT(); asm volatile("" ::: "memory");
    const int c = lane & 7;
#pragma unroll
    for (int j = 0; j < 4; ++j) { const int n = (lane >> 3) + 8 * j; const LAS float* s = scr + (8 * c) * 33 + n;
        v4u o; o.x = pk2(s[0 * 33], s[1 * 33]); o.y = pk2(s[2 * 33], s[3 * 33]); o.z = pk2(s[4 * 33], s[5 * 33]); o.w = pk2(s[6 * 33], s[7 * 33]);
        *(GAS v4u*)(t.WT + (size_t)(drow + n) * t.K + k0 + 8 * c) = o; }
    LDS_WAIT(); asm volatile("" ::: "memory");
}

struct Args { const float* in[17]; float* out; unsigned char* ws; int ph_lo, ph_hi, coop, pad; };
#define CAS __attribute__((address_space(4)))
typedef const float* const CAS* kin_t;
struct KA { kin_t in; float* out; unsigned char* ws; };
__device__ __forceinline__ KA get_ka() { const CAS char* kp = (const CAS char*)__builtin_amdgcn_kernarg_segment_ptr(); asm volatile("" : "+s"(kp));
    KA a; a.in = (kin_t)kp; a.out = *(float* const CAS*)((const CAS char*)kp + 136); a.ws = *(unsigned char* const CAS*)((const CAS char*)kp + 144); return a; }
static_assert(offsetof(Args, out) == 136 && offsetof(Args, ws) == 144, "Args layout");

__device__ __forceinline__ void p0_prologue(const KA& A, LAS unsigned char* lds, int gw, int NGW, int wave, int lane) {
    LAS float* scr = (LAS float*)(lds + wave * 16384);
    constexpr int I_G = 2048, I_D = 2048, I_Q = 1536, I_O = 512, PER_LAYER = 4 * I_G + 2 * I_D + I_Q + I_O;
    auto decode = [&](int it) -> TrItem { TrItem t; const int l = it / PER_LAYER; int r = it - l * PER_LAYER; unsigned char* wl = A.ws + WS_W + (size_t)l * W_LAYER;
        if (r < 4 * I_G) { const int w = r / I_G, j = w >> 1, up = w & 1; r -= w * I_G;
            t.W = A.in[up ? 11 : 10] + (size_t)(l * 2 + j) * 1024 * 4096; t.g = A.in[7] + (size_t)(3 * l + 2 * j) * 1024; t.K = 1024; t.N = 4096; t.WT = (bf16*)(wl + (j ? W_GUB : W_GUA)); t.mode = 1 + up; t.item = r; return t; }
        r -= 4 * I_G;
        if (r < 2 * I_D) { const int j = r / I_D; r -= j * I_D; t.W = A.in[12] + (size_t)(l * 2 + j) * 4096 * 1024; t.g = nullptr; t.K = 4096; t.N = 1024; t.WT = (bf16*)(wl + (j ? W_DB : W_DA)); t.mode = 0; t.item = r; return t; }
        r -= 2 * I_D;
        if (r < I_Q) { t.W = A.in[8] + (size_t)l * 1024 * 3072; t.g = A.in[7] + (size_t)(3 * l + 1) * 1024; t.K = 1024; t.N = 3072; t.WT = (bf16*)(wl + W_QKV); t.mode = 0; t.item = r; return t; }
        r -= I_Q; t.W = A.in[9] + (size_t)l * 1024 * 1024; t.g = nullptr; t.K = 1024; t.N = 1024; t.WT = (bf16*)(wl + W_O); t.mode = 0; t.item = r; return t; };
    for (int it = gw; it < 2 * PER_LAYER; it += 2 * NGW) {
        const bool two = it + NGW < 2 * PER_LAYER;
        const TrItem t0 = decode(it), t1 = decode(two ? it + NGW : it);
        f32x4 v0[8], v1[8]; tr_load(t0, lane, v0); if (two) tr_load(t1, lane, v1);
        tr_finish(t0, lane, v0, scr); if (two) tr_finish(t1, lane, v1, scr);
    }
    { bf16* wq1 = (bf16*)(A.ws + WS_W + W_LAYER + W_QKV) + (size_t)3072 * 1024; const float* wf = A.in[14];
      for (int i = gw * 64 + lane; i < 256 * 1024; i += NGW * 64) { const int n = i >> 10, k = i & 1023; wq1[i] = (n < 16) ? (bf16)f2bf(wf[k * 16 + n] * A.in[7][4 * 1024 + k]) : (bf16)0; } }
    float* rowss = (float*)(A.ws + WS_ROWSS); float* x = A.out; bf16* xg = (bf16*)(A.ws + WS_XG); const float* g0 = A.in[7];
    f32x4 gv[4];
#pragma unroll
    for (int j = 0; j < 4; ++j) gv[j] = *(const f32x4*)(g0 + 4 * lane + 256 * j);
    for (int m0 = gw; m0 < MTOT; m0 += 2 * NGW) {
        f32x4 v[2][4]; const bool two = m0 + NGW < MTOT;
#pragma unroll
        for (int q = 0; q < 2; ++q) { const int m = (q && two) ? m0 + NGW : m0; const float* src = (m < MP) ? A.in[0] + (size_t)m * 1024 : A.in[1] + (size_t)(m - MP) * 1024;
#pragma unroll
            for (int j = 0; j < 4; ++j) v[q][j] = *(const f32x4*)(src + 4 * lane + 256 * j); }
#pragma unroll
        for (int q = 0; q < 2; ++q) { if (q && !two) break; const int m = q ? m0 + NGW : m0; float s = 0.f;
#pragma unroll
            for (int j = 0; j < 4; ++j) s += (v[q][j].x * v[q][j].x + v[q][j].y * v[q][j].y) + (v[q][j].z * v[q][j].z + v[q][j].w * v[q][j].w);
            s = wave_sum(s);
#pragma unroll
            for (int j = 0; j < 4; ++j) { const f32x4 a = v[q][j];
                *(unsigned long long*)(xg + (size_t)m * 1024 + 4 * lane + 256 * j) = (unsigned long long)pk2(a.x, a.y) | ((unsigned long long)pk2(a.z, a.w) << 32); }
            if (lane == 0) rowss[m] = s; }
    }
    for (int i = gw * 64 + lane; i < 6 * MTOT + 128 * 16 + 64; i += NGW * 64) rowss[MTOT + i] = 0.f;
}


typedef float f32x4s __attribute__((ext_vector_type(4)));
template <int NB> __device__ __forceinline__ void skinny_mma(const bf16* A, const bf16* B0, const bf16* B1, int K, int wave, int lane, LAS unsigned char* lds, f32x4s (&acc)[NB]) {
    const int fr = lane & 15, fq = lane >> 4, rf = wave & 3, kh = wave >> 2, KH = K >> 1;
    const bf16* ap = A + (size_t)(16 * rf + fr) * K + kh * KH + 8 * fq;
    const bf16* bp0 = B0 + (size_t)fr * K + kh * KH + 8 * fq; const bf16* bp1 = (NB == 2) ? B1 + (size_t)fr * K + kh * KH + 8 * fq : bp0;
#pragma unroll
    for (int nb = 0; nb < NB; ++nb) acc[nb] = (f32x4s){0.f, 0.f, 0.f, 0.f};
    constexpr int U = 16;
#pragma unroll 1
    for (int k0 = 0; k0 < KH; k0 += 32 * U) { bf16x8 av[U], bv[U][NB];
#pragma unroll
        for (int s = 0; s < U; ++s) { av[s] = *(const bf16x8*)(ap + k0 + 32 * s); bv[s][0] = *(const bf16x8*)(bp0 + k0 + 32 * s); if (NB == 2) bv[s][1] = *(const bf16x8*)(bp1 + k0 + 32 * s); }
#pragma unroll
        for (int s = 0; s < U; ++s)
#pragma unroll
            for (int nb = 0; nb < NB; ++nb) acc[nb] = __builtin_amdgcn_mfma_f32_16x16x32_bf16(av[s], bv[s][nb], acc[nb], 0, 0, 0); }
    LAS f32x4s* red = (LAS f32x4s*)lds;
    if (kh == 1) {
#pragma unroll
        for (int nb = 0; nb < NB; ++nb) red[(rf * 64 + lane) * NB + nb] = acc[nb]; }
    __syncthreads();
    if (kh == 0) {
#pragma unroll
        for (int nb = 0; nb < NB; ++nb) acc[nb] += red[(rf * 64 + lane) * NB + nb]; }
    __syncthreads();
}
template <int NB, int NRF> __device__ __forceinline__ void skinny_full(const bf16* A, const bf16* B0, const bf16* B1, int K, int wave, int lane, f32x4s (&acc)[NB][NRF]) {
    const int fr = lane & 15, fq = lane >> 4;
    const bf16* ap = A + (size_t)(16 * NRF * wave + fr) * K + 8 * fq;
    const bf16* bp0 = B0 + (size_t)fr * K + 8 * fq; const bf16* bp1 = (NB == 2) ? B1 + (size_t)fr * K + 8 * fq : bp0;
#pragma unroll
    for (int nb = 0; nb < NB; ++nb)
#pragma unroll
        for (int a = 0; a < NRF; ++a) acc[nb][a] = (f32x4s){0.f, 0.f, 0.f, 0.f};
    constexpr int U = 8;
#pragma unroll 1
    for (int k0 = 0; k0 < K; k0 += 32 * U) { bf16x8 av[U][NRF], bv[U][NB];
#pragma unroll
        for (int s = 0; s < U; ++s) {
#pragma unroll
            for (int a = 0; a < NRF; ++a) av[s][a] = *(const bf16x8*)(ap + (size_t)(16 * a) * K + k0 + 32 * s);
            bv[s][0] = *(const bf16x8*)(bp0 + k0 + 32 * s); if (NB == 2) bv[s][1] = *(const bf16x8*)(bp1 + k0 + 32 * s); }
#pragma unroll
        for (int s = 0; s < U; ++s)
#pragma unroll
            for (int nb = 0; nb < NB; ++nb)
#pragma unroll
                for (int a = 0; a < NRF; ++a) acc[nb][a] = __builtin_amdgcn_mfma_f32_16x16x32_bf16(av[s][a], bv[s][nb], acc[nb][a], 0, 0, 0); }
}
__device__ __forceinline__ void skinny_gateup(const KA& A, LAS unsigned char* lds, int G, int bx, int wave, int lane, const bf16* Wgu, const float* rowss) {
    const bf16* XG = (const bf16*)(A.ws + WS_XG) + (size_t)MP * 1024; bf16* ACT = (bf16*)(A.ws + WS_ACT);
    const int fr = lane & 15, fq = lane >> 4;
    for (int sl = bx; sl < 256; sl += G) { const int c0 = 16 * sl; const int brow = (c0 >> 7) * 256 + (c0 & 127);
        f32x4s acc[2][2]; skinny_full<2, 2>(XG, Wgu + (size_t)brow * 1024, Wgu + (size_t)(brow + 128) * 1024, 1024, wave, lane, acc);
#pragma unroll
        for (int a = 0; a < 2; ++a)
#pragma unroll
            for (int i = 0; i < 4; ++i) { const int row = MP + 16 * (2 * wave + a) + 4 * fq + i; const float rs = pg8::rstd_of(rowss[row]);
                ACT[(size_t)row * 4096 + c0 + fr] = (bf16)f2bf(pg8::silu_mul(acc[0][a][i] * rs, acc[1][a][i] * rs)); } }
}
__device__ __forceinline__ void skinny_resid(const KA& A, const float* xin32  , LAS unsigned char* lds, int G, int bx, int wave, int lane, const bf16* Ain, int K, const bf16* Wt, bf16* xb, float* rowss_next, float alpha) {
    const int fr = lane & 15, fq = lane >> 4, rf = wave & 3;
    for (int it = bx; it < 256; it += G) { const int sl = it >> 2, rg = it & 3, c0 = 16 * sl;
        f32x4s acc[1]; skinny_mma<1>(Ain + (size_t)(MP + 64 * rg) * K, Wt + (size_t)c0 * K, nullptr, K, wave, lane, lds, acc);
        if (wave < 4) {
#pragma unroll
            for (int i = 0; i < 4; ++i) { const int row = MP + 64 * rg + 16 * rf + 4 * fq + i; const size_t o = (size_t)row * 1024 + c0 + fr;
                const float v = (xin32 ? xin32[o] : bf2f(xb[o])) + alpha * acc[0][i]; xb[o] = (bf16)f2bf(v);
                float ss = v * v; ss += __shfl_xor(ss, 1); ss += __shfl_xor(ss, 2); ss += __shfl_xor(ss, 4); ss += __shfl_xor(ss, 8);
                if (fr == 0) __hip_atomic_fetch_add(rowss_next + row, ss, __ATOMIC_RELAXED, __HIP_MEMORY_SCOPE_AGENT); } } }
}
__device__ __forceinline__ void skinny_qkv(const KA& A, LAS unsigned char* lds, int G, int bx, int wave, int lane, const bf16* Wqkv, const float* rowss, int fox) {
    const bf16* XG = (const bf16*)(A.ws + WS_XG) + (size_t)MP * 1024;
    const int fr = lane & 15, fq = lane >> 4;
    for (int sl = bx; sl < 192; sl += G) { const int c0 = 16 * sl;
        f32x4s acc[1][2]; skinny_full<1, 2>(XG, Wqkv + (size_t)c0 * 1024, nullptr, 1024, wave, lane, acc);
        const int t = sl >> 6, cin = c0 - 1024 * t + fr; bf16* bd = (bf16*)(A.ws + (t == 0 ? WS_QO : t == 1 ? WS_KB : WS_VB));
#pragma unroll
        for (int a = 0; a < 2; ++a)
#pragma unroll
            for (int i = 0; i < 4; ++i) { const int rl = 16 * (2 * wave + a) + 4 * fq + i, row = MP + rl; const float v = acc[0][a][i] * pg8::rstd_of(rowss[row]);
                bd[(size_t)row * 1024 + cin] = (bf16)f2bf(t == 0 ? v * attn_body::C2 : v);
                if (t == 1) A.out[(fox ? O_FKS : O_BKS) + (size_t)rl * 1024 + cin] = v; else if (t == 2) A.out[(fox ? O_FVS : O_BVS) + (size_t)rl * 1024 + cin] = v; } }
}
__device__ __forceinline__ void skinny_logf(const KA& A, LAS unsigned char* lds, int G, int bx, int wave, int lane, const bf16* Wf  , const float* rowss) {
    const bf16* XG = (const bf16*)(A.ws + WS_XG); float* blocktot = (float*)(A.ws + WS_BTOT);
    const int fr = lane & 15, fq = lane >> 4; const float bfr = A.in[15][fr];
    for (int it = bx; it < MTOT / 128; it += G) {
        f32x4s acc[1][1]; skinny_full<1, 1>(XG + (size_t)(128 * it) * 1024, Wf, nullptr, 1024, wave, lane, acc);
        float tot = 0.f;
#pragma unroll
        for (int i = 0; i < 4; ++i) { const int row = 128 * it + 16 * wave + 4 * fq + i; const float z = acc[0][0][i] * pg8::rstd_of(rowss[row]) + bfr; const float ee = __builtin_amdgcn_exp2f(-L2E * fabsf(z));
            const float big = 0.6931471805599453f * __builtin_amdgcn_logf(1.0f + ee), sm = ee * (1.0f - ee * (0.5f - ee * (0.3333333333f - 0.25f * ee)));
            const float lfv = fminf(z, 0.f) - (ee < 0.03f ? sm : big); tot += lfv;
            if (row < MP) A.out[O_FLP + (size_t)row * 16 + fr] = lfv; else A.out[O_FLS + (size_t)(row - MP) * 16 + fr] = lfv; }
        tot += __shfl_xor(tot, 16); tot += __shfl_xor(tot, 32);
        if (fq == 0 && it < MP / 128) __hip_atomic_fetch_add(blocktot + (it >> 1) * 16 + fr, tot, __ATOMIC_RELAXED, __HIP_MEMORY_SCOPE_AGENT); }
}
template <int FOX> __device__ __forceinline__ void sample_unit(int s, int h, LAS unsigned char* lds, const KA& A) {
    constexpr int NC = FOX ? 1024 : 512, NK = NC + 16, SP = 1056;
    int tid_ = threadIdx.x; asm volatile("" : "+v"(tid_)); const int tid = tid_, lane = tid & 63, wave = tid >> 6;
    LAS float* Qs = (LAS float*)lds;
    LAS float* cum = (LAS float*)(lds + 4096);
    LAS float* linv = (LAS float*)(lds + 8320);
    LAS float* S = (LAS float*)(lds + 8448);
    bf16* QO = (bf16*)(A.ws + WS_QO);
    const float* ck = A.in[FOX ? 4 : 2]; const float* cv = A.in[FOX ? 5 : 3];
    const float* nk = A.out + (FOX ? O_FKS : O_BKS); const float* nv = A.out + (FOX ? O_FVS : O_BVS);
    { const int e = tid * 2, i = e >> 6, d = e & 63; const unsigned w = *(const unsigned*)(QO + (size_t)(MP + s * 16 + i) * 1024 + h * 64 + d);
      Qs[i * 64 + d] = bf2f((unsigned short)(w & 0xffffu)); Qs[i * 64 + d + 1] = bf2f((unsigned short)(w >> 16)); }
    if (FOX && wave == 0) { const float* clf = A.in[6]; const float* nlf = A.out + O_FLS; float carry = 0.f;
        for (int c = 0; c < 17; ++c) { const int j = c * 64 + lane;
            float v = (j < 1024) ? clf[(size_t)(s * 1024 + j) * 16 + h] : ((j < 1040) ? nlf[(size_t)(s * 16 + j - 1024) * 16 + h] : 0.f);
#pragma unroll
            for (int d = 1; d < 64; d <<= 1) { const float t = __shfl_up(v, d); if (lane >= d) v += t; }
            v += carry; if (j < 1040) cum[j] = v; carry = __shfl(v, 63); } }
    __syncthreads();
    const float* relb = A.in[13] + h;
    for (int j = tid; j < NK; j += 512) {
        const float* kp = (j < NC) ? ck + ((size_t)(s * NC + j) * 16 + h) * 64 : nk + (size_t)(s * 16 + j - NC) * 1024 + h * 64;
        f32x4 kr[16];
#pragma unroll
        for (int q = 0; q < 16; ++q) kr[q] = *(const f32x4*)(kp + 4 * q);
        const float cj = FOX ? cum[j] : 0.f;
#pragma unroll 1
        for (int i = 0; i < 16; ++i) { float a = 0.f;
#pragma unroll
            for (int q = 0; q < 16; ++q) { const f32x4 qv = *(const LAS f32x4*)(Qs + i * 64 + 4 * q); a += (qv.x * kr[q].x + qv.y * kr[q].y) + (qv.z * kr[q].z + qv.w * kr[q].w); }
            float bias; bool valid = true;
            if (FOX) { bias = L2E * (cum[NC + i] - cj); valid = (j <= NC + i); }
            else { int dist = 512 + i - j; dist = dist > 256 ? 256 : dist; dist = dist < -256 ? -256 : dist; bias = L2E * relb[(dist + 256) * 16]; }
            S[i * SP + j] = valid ? a + bias : -INFINITY; }
    }
    __syncthreads();
#pragma unroll 1
    for (int rr = 0; rr < 2; ++rr) { const int i = wave * 2 + rr; float m = -INFINITY;
        for (int j = lane; j < NK; j += 64) m = fmaxf(m, S[i * SP + j]);
#pragma unroll
        for (int o = 1; o < 64; o <<= 1) m = fmaxf(m, __shfl_xor(m, o));
        float l = 0.f;
        for (int j = lane; j < NK; j += 64) { const float p = __builtin_amdgcn_exp2f(S[i * SP + j] - m); S[i * SP + j] = p; l += p; }
        l = wave_sum(l); if (lane == 0) linv[i] = 1.0f / l; }
    __syncthreads();
    {
      LAS float* red = (LAS float*)(lds + 8448 + 16 * SP * 4);
      float o[16];
#pragma unroll
      for (int i = 0; i < 16; ++i) o[i] = 0.f;
#pragma unroll 8
      for (int j = wave; j < NK; j += 8) { const float v = (j < NC) ? cv[((size_t)(s * NC + j) * 16 + h) * 64 + lane] : nv[(size_t)(s * 16 + j - NC) * 1024 + h * 64 + lane];
#pragma unroll
          for (int i = 0; i < 16; ++i) o[i] += S[i * SP + j] * v; }
#pragma unroll
      for (int i = 0; i < 16; ++i) red[(wave * 16 + i) * 64 + lane] = o[i];
      __syncthreads();
#pragma unroll
      for (int rr = 0; rr < 2; ++rr) { const int i = wave * 2 + rr; float a = 0.f;
#pragma unroll
          for (int w = 0; w < 8; ++w) a += red[(w * 16 + i) * 64 + lane];
          ((bf16*)(A.ws + WS_OB))[(size_t)(MP + s * 16 + i) * 1024 + h * 64 + lane] = (bf16)f2bf(a * linv[i]); } }
    __syncthreads();
}

__device__ __forceinline__ void cumsum_phase(const KA& A, LAS unsigned char* lds, int G) {
    int tid_ = threadIdx.x; asm volatile("" : "+v"(tid_)); const int tid = tid_, h = tid & 15, j = tid >> 4;
    LAS float* tot = (LAS float*)lds;
    const float* lf = A.out + O_FLP; const float* bt = (const float*)(A.ws + WS_BTOT); float* cs2 = (float*)(A.ws + WS_CS2);
    {
        const bf16* KBp = (const bf16*)(A.ws + WS_KB); unsigned* kmax2 = (unsigned*)(A.ws + WS_BTOT) + 2048;
        const int lane = tid & 63, gw = blockIdx.x * NWAVES + (tid >> 6), NGW = G * NWAVES, b = gw & 3; float mx = 0.f;
#pragma unroll 4
        for (int r = gw >> 2; r < SEQL; r += (NGW >> 2)) { const bf16* kr = KBp + (size_t)(b * SEQL + r) * 1024 + 16 * lane; const bf16x8 v0 = *(const bf16x8*)kr, v1 = *(const bf16x8*)(kr + 8); float s2 = 0.f;
#pragma unroll
            for (int j = 0; j < 8; ++j) { const float f0 = bf2f((unsigned short)v0[j]), f1 = bf2f((unsigned short)v1[j]); s2 += f0 * f0 + f1 * f1; }
            s2 += __shfl_xor(s2, 1); s2 += __shfl_xor(s2, 2); mx = fmaxf(mx, s2); }
        if ((lane & 3) == 0) __hip_atomic_fetch_max(kmax2 + b * 16 + (lane >> 2), __float_as_uint(mx), __ATOMIC_RELAXED, __HIP_MEMORY_SCOPE_AGENT);
    }
    for (int it = blockIdx.x; it < 128; it += G) { const int b = it >> 5, seg = it & 31;
        float base = 0.f; for (int s2 = 0; s2 < seg; ++s2) base += bt[(b * 32 + s2) * 16 + h];
        const int t0 = seg * 256 + j * 8; float p[8]; float run = 0.f;
#pragma unroll
        for (int i = 0; i < 8; ++i) { run += lf[(size_t)(b * 8192 + t0 + i) * 16 + h]; p[i] = run; }
        tot[j * 16 + h] = run; __syncthreads();
        float off = base; for (int j2 = 0; j2 < j; ++j2) off += tot[j2 * 16 + h];
        float* dst = cs2 + (size_t)(b * 16 + h) * 8192 + t0;
        *(f32x4*)dst = (f32x4){L2E * (off + p[0]), L2E * (off + p[1]), L2E * (off + p[2]), L2E * (off + p[3])};
        *(f32x4*)(dst + 4) = (f32x4){L2E * (off + p[4]), L2E * (off + p[5]), L2E * (off + p[6]), L2E * (off + p[7])};
        __syncthreads(); }
}

__global__ void __launch_bounds__(NWAVES * 64, 2) mk_fwd(Args args) {
    extern __shared__ __attribute__((aligned(16))) unsigned char lds[];
    LAS unsigned char* lds3 = (LAS unsigned char*)lds;
    volatile LAS unsigned* MISC = (volatile LAS unsigned*)(lds3 + MISC_OFF);
    const int tid0 = threadIdx.x;
    gu32* ctl = (gu32*)(args.ws + WS_CTL);
    for (int u = tid0; u < (LDS_BYTES - LDSCTL_OFF) / 4; u += NWAVES * 64) ((LAS unsigned*)(lds3 + LDSCTL_OFF))[u] = 0u;
    __syncthreads();
    XcdBarrier bar; bar.bar = (unsigned*)(ctl + CW_BAR); bar.x = 0; bar.st = nullptr;
    if (args.coop) bar = xcd_barrier_post((unsigned*)(ctl + CW_BAR), MISC + 8);

    int rep = 0;
    for (int p = args.ph_lo; p < args.ph_hi; ++p) {
        bool did = true;
        const KA A = get_ka();
        int tid_ = threadIdx.x; asm volatile("" : "+v"(tid_)); const int tid = tid_, lane = tid & 63, wave = __builtin_amdgcn_readfirstlane(tid >> 6);
        int G_ = gridDim.x, bx_ = blockIdx.x; asm volatile("" : "+s"(G_), "+s"(bx_)); const int G = G_, bx = bx_; const int vcu = (G % 8 == 0) ? (bx % 8) * (G / 8) + bx / 8 : bx;
        unsigned char* ws = A.ws;
        float* rowss = (float*)(ws + WS_ROWSS);
        bf16* XG = (bf16*)(ws + WS_XG); bf16* ACT = (bf16*)(ws + WS_ACT); bf16* QO = (bf16*)(ws + WS_QO); bf16* KB = (bf16*)(ws + WS_KB); bf16* VB = (bf16*)(ws + WS_VB);
        if (p == 0) {
#ifndef NO_P0
 p0_prologue(A, lds3, vcu * NWAVES + wave, G * NWAVES, wave, lane);
#endif
 }
        else if (p == N_PHASES - 1) {
            const float* gf = A.in[16]; f32x4 gv[4];
#pragma unroll
            for (int j = 0; j < 4; ++j) gv[j] = *(const f32x4*)(gf + 4 * lane + 256 * j);
            for (int m0 = vcu * NWAVES + wave; m0 < MTOT; m0 += 2 * G * NWAVES) {
                unsigned long long w[2][4]; float rs[2];
#pragma unroll
                for (int q = 0; q < 2; ++q) { const int m = m0 + q * G * NWAVES; if (m < MTOT) { rs[q] = rowss[6 * MTOT + m]; const bf16* xr = XG + (size_t)m * 1024 + 4 * lane;
#pragma unroll
                        for (int j = 0; j < 4; ++j) w[q][j] = *(const unsigned long long*)(xr + 256 * j); } }
#pragma unroll
                for (int q = 0; q < 2; ++q) { const int m = m0 + q * G * NWAVES; if (m < MTOT) { const float r = pg8::rstd_of(rs[q]); float* yr = A.out + (size_t)m * 1024 + 4 * lane;
#pragma unroll
                        for (int j = 0; j < 4; ++j) { const unsigned long long ww = w[q][j];
                            const f32x4 v = {bf2f((unsigned short)(ww & 0xffffu)), bf2f((unsigned short)((ww >> 16) & 0xffffu)), bf2f((unsigned short)((ww >> 32) & 0xffffu)), bf2f((unsigned short)(ww >> 48))};
                            *(f32x4*)(yr + 256 * j) = v * r * gv[j]; } } } }
        } else {
            const int l = (p - 1) >> 3, k = (p - 1) & 7;
            unsigned char* wl = ws + WS_W + (size_t)l * W_LAYER;
            if (k == 0 || k == 6) {
                pg8::Gemm g{XG, (const bf16*)(wl + (k ? W_GUB : W_GUA)), MP, 2 * DFF, DMODEL}; pg8::StaticOrder S; S.init(MP, 2 * DFF, G, bx);
                pg8::EpiGateUp E{ACT, rowss + (size_t)(3 * l + (k ? 2 : 0)) * MTOT};

#ifndef NO_GU
pg8::gemm_phase<pg8::EpiGateUp, pg8::StaticOrder, true, true>(lds3 + RING_OFF, g, S, E);
#endif
                skinny_gateup(A, lds3 + RING_OFF, G, bx, wave, lane, (const bf16*)(wl + (k ? W_GUB : W_GUA)), rowss + (size_t)(3 * l + (k ? 2 : 0)) * MTOT);
#ifdef PROBE_SKINNY
                for (int rp_ = 0; rp_ < 4; ++rp_) skinny_gateup(A, lds3 + RING_OFF, G, bx, wave, lane, (const bf16*)(wl + (k ? W_GUB : W_GUA)), rowss + (size_t)(3 * l + (k ? 2 : 0)) * MTOT);
#endif

            } else if (k == 1 || k == 7 || k == 5) {
                const int nn = (k == 1) ? 3 * l + 1 : (k == 5) ? 3 * l + 2 : 3 * l + 3;
                pg8::Gemm g{(k == 5) ? (const bf16*)(ws + WS_OB) : ACT, (const bf16*)(wl + ((k == 1) ? W_DA : (k == 7) ? W_DB : W_O)), MP, DMODEL, (k == 5) ? DMODEL : DFF}; pg8::StaticOrder S; S.init(MP, DMODEL, G, bx);
                if (p == 2) { pg8::EpiResid<true> E{A.in[0], XG, rowss + (size_t)nn * MTOT, (k == 5) ? 1.0f : 0.5f};
#ifndef NO_RES
                    pg8::gemm_phase<pg8::EpiResid<true>, pg8::StaticOrder, true, true>(lds3 + RING_OFF, g, S, E);
#endif
                } else { pg8::EpiResid<false> E{nullptr, XG, rowss + (size_t)nn * MTOT, (k == 5) ? 1.0f : 0.5f};
#ifndef NO_RES
                    pg8::gemm_phase<pg8::EpiResid<false>, pg8::StaticOrder, true, true>(lds3 + RING_OFF, g, S, E);
#endif
                }
                skinny_resid(A, (p == 2) ? A.in[1] - (size_t)MP * 1024 : nullptr, lds3 + RING_OFF, G, bx, wave, lane, (k == 5) ? (const bf16*)(ws + WS_OB) : ACT, (k == 5) ? DMODEL : DFF, (const bf16*)(wl + ((k == 1) ? W_DA : (k == 7) ? W_DB : W_O)), XG, rowss + (size_t)nn * MTOT, (k == 5) ? 1.0f : 0.5f);
            } else if (k == 2) {
                const int N = 3072;
                pg8::Gemm g{XG, (const bf16*)(wl + W_QKV), MP, N, DMODEL}; pg8::StaticOrder S; S.init(MP, N, G, bx);
                pg8::EpiQKV<QkvOff> E{ws, A.out, A.in[15], l, attn_body::C2};

#ifndef NO_QKV
pg8::gemm_phase<pg8::EpiQKV<QkvOff>, pg8::StaticOrder, true, true>(lds3 + RING_OFF, g, S, E);
#endif
                skinny_qkv(A, lds3 + RING_OFF, G, bx, wave, lane, (const bf16*)(wl + W_QKV), rowss + (size_t)(3 * l + 1) * MTOT, l);
                if (l == 1) skinny_logf(A, lds3 + RING_OFF, G, bx, wave, lane, (const bf16*)(wl + W_QKV) + (size_t)3072 * 1024, rowss + (size_t)(3 * l + 1) * MTOT);

            } else if (k == 3) {
                if (l == 1) cumsum_phase(A, lds3, G); else did = false;
            } else {
                const attn_body::bf16* Qb = (const attn_body::bf16*)QO; const attn_body::bf16* Kb = (const attn_body::bf16*)KB; const attn_body::bf16* Vb = (const attn_body::bf16*)VB;
                if (l == 1) {
                    const float* cs2 = (const float*)(ws + WS_CS2); const unsigned* kmax2 = (const unsigned*)(ws + WS_BTOT) + 2048;
                    volatile LAS unsigned* qslot = (volatile LAS unsigned*)(lds3 + RING_OFF + attn_body::ATTN_LDS_BYTES);
#pragma unroll 1
                    for (;;) { if (tid == 0) *qslot = __hip_atomic_fetch_add((unsigned*)(ws + WS_CTL) + CW_QUEUE, 1u, __ATOMIC_RELAXED, __HIP_MEMORY_SCOPE_AGENT);
                        __syncthreads(); const unsigned idx = *qslot; __syncthreads();
                        if (idx >= 2048u + 256u) break;
                        if (idx < 2048u) { const int qb = 31 - (int)(idx >> 6), bh = (int)(idx & 63u);
                            const float kmx = sqrtf(__uint_as_float(__hip_atomic_load(kmax2 + bh, __ATOMIC_RELAXED, __HIP_MEMORY_SCOPE_AGENT))) * 1.01f;
#ifndef NO_FOX
                            attn_body::attn_unit<0, 8>(bh >> 4, bh & 15, qb, Qb, Kb, Vb, (attn_body::bf16*)(ws + WS_OB), (char*)lds + RING_OFF, cs2 + (size_t)bh * 8192, nullptr, kmx);
#endif
                        } else { const int u = (int)idx - 2048;
#ifndef NO_SAMPLE
                            sample_unit<1>(u >> 4, u & 15, lds3 + RING_OFF, A);
#endif
                        } }
                } else {
                    int prev_bh = -1;
#pragma unroll 1
                    for (int u = vcu * (2048 / 256); u < 2048; u += G * (2048 / 256)) {
#pragma unroll 1
                        for (int i = 0; i < 2048 / 256; ++i) { const int bh = (u + i) >> 5, qb = (u + i) & 31;
#ifndef NO_BAND
                            attn_body::attn_unit<1, 8>(bh >> 4, bh & 15, qb, Qb, Kb, Vb, (attn_body::bf16*)(ws + WS_OB), (char*)lds + RING_OFF, nullptr, (bh & 15) == (prev_bh & 15) && prev_bh >= 0 ? nullptr : A.in[13] + (bh & 15), 0.f);
#endif
                            prev_bh = bh; } }
#ifndef NO_SAMPLE
for (int u = bx; u < 256; u += G) sample_unit<0>(u >> 4, u & 15, lds3 + RING_OFF, A);
#endif

                }
            }
        }
        const bool again = (((PROBE_MASK >> p) & 1u) != 0u) && rep == 0;
        if (did && (p + 1 < args.ph_hi || again)) {
            if (p == 0 && !again) { __syncthreads(); cg::this_grid().sync(); } else xcd_barrier(bar);
        }
        if (again) { rep = 1; --p; } else rep = 0;
    }
}

extern "C" void kernel_launch(void* const* d_in, const int* in_sizes, int n_in, void* d_out, int out_size, void* d_ws, size_t ws_size, hipStream_t stream) {
    static int grid = 0;
    if (grid == 0) {
        if (n_in != 17 || out_size != (int)O_END || ws_size < WS_END) { fprintf(stderr, "kernel_launch: unexpected shapes (n_in %d out %d ws %zu)\n", n_in, out_size, ws_size); grid = -1; return; }
        int dev = 0, cus = 0, per_cu = 0;
        if (hipGetDevice(&dev) != hipSuccess || hipDeviceGetAttribute(&cus, hipDeviceAttributeMultiprocessorCount, dev) != hipSuccess) { grid = -1; return; }
        if (hipFuncSetAttribute((const void*)mk_fwd, hipFuncAttributeMaxDynamicSharedMemorySize, LDS_BYTES) != hipSuccess) { fprintf(stderr, "kernel_launch: hipFuncSetAttribute failed\n"); grid = -1; return; }
        if (hipOccupancyMaxActiveBlocksPerMultiprocessor(&per_cu, (const void*)mk_fwd, NWAVES * 64, LDS_BYTES) != hipSuccess || per_cu < 1) { fprintf(stderr, "kernel_launch: occupancy query says %d\n", per_cu); per_cu = 1; }
        (void)hipGetLastError();
        grid = cus * per_cu;
        if (grid > 256) grid = 256;
    }
    if (grid < 0) return;
    if (hipMemsetAsync((char*)d_ws + WS_CTL, 0, CTL_ZERO_BYTES, stream) != hipSuccess) { fprintf(stderr, "kernel_launch: memset failed\n"); return; }
    Args a{};
    for (int i = 0; i < 17; ++i) a.in[i] = (const float*)d_in[i];
    a.out = (float*)d_out; a.ws = (unsigned char*)d_ws; a.pad = 0;
#if MK_N_LAUNCHES == 1
    a.ph_lo = 0; a.ph_hi = N_PHASES; a.coop = 1;
    void* kargs[] = {&a};
    hipError_t e = hipLaunchCooperativeKernel((const void*)mk_fwd, dim3(grid), dim3(NWAVES * 64), kargs, LDS_BYTES, stream);
    if (e != hipSuccess) fprintf(stderr, "kernel_launch: cooperative launch failed: %s (grid %d)\n", hipGetErrorString(e), grid);
#else
    for (int p = 0; p < N_PHASES; ++p) {
        if (p == 4) continue;
        a.ph_lo = p; a.ph_hi = p + 1; a.coop = 0;
        hipLaunchKernelGGL(mk_fwd, dim3(grid), dim3(NWAVES * 64), LDS_BYTES, stream, a);
    }
#endif
}
```
